# Optimizing an MI355X kernel written in HIP

```python
import math
import jax, jax.numpy as jnp
from jax import lax
import numpy as np

D_MODEL = 2048
BATCH = 4
SEQ = 4096
DEPTH = 1

ROPE_THETA = 10000.0
NORM_EPS = 1e-6
Q_BLOCK = 128
NEG_INF = -1e30

MLA_HEADS = 8
MLA_NOPE_DIM = 128
MLA_ROPE_DIM = 64
MLA_QK_DIM = MLA_NOPE_DIM + MLA_ROPE_DIM
MLA_V_DIM = 128
MLA_Q_RANK = 512
MLA_KV_RANK = 256

DIFF_HEADS = 8
DIFF_HEAD_DIM = 64
DIFF_V_DIM = 2 * DIFF_HEAD_DIM

D_FF = 5632
CONV_WIDTH = 3

N_BRANCHES = 2
IN_SPLITS = (
    MLA_Q_RANK,
    MLA_KV_RANK,
    MLA_ROPE_DIM,
    DIFF_HEADS * 2 * DIFF_HEAD_DIM,
    DIFF_HEADS * 2 * DIFF_HEAD_DIM,
    DIFF_HEADS * DIFF_V_DIM,
    N_BRANCHES * D_MODEL,
)
IN_WIDTH = sum(IN_SPLITS)
MIX_WIDTH_MLA = MLA_HEADS * MLA_V_DIM
MIX_WIDTH_DIFF = DIFF_HEADS * DIFF_V_DIM

kernel_name = "hybrid_mla_diffattn_convffn_adaln"


def rms_norm(x, g):
    xf = x.astype(jnp.float32)
    y = xf * lax.rsqrt(jnp.mean(xf * xf, axis=-1, keepdims=True) + NORM_EPS)
    return (y * g.astype(jnp.float32)).astype(x.dtype)


def rope(x, positions):
    d = x.shape[-1]
    inv_freq = ROPE_THETA ** (-jnp.arange(0, d, 2, dtype=jnp.float32) / d)
    ang = positions.astype(jnp.float32)[..., None] * inv_freq
    cos = jnp.cos(ang)[:, :, None, :]
    sin = jnp.sin(ang)[:, :, None, :]
    xf = x.astype(jnp.float32)
    x1, x2 = xf[..., : d // 2], xf[..., d // 2:]
    return jnp.concatenate([x1 * cos - x2 * sin, x2 * cos + x1 * sin], axis=-1).astype(x.dtype)


def _causal_mask(i, seq):
    q_idx = i * Q_BLOCK + jnp.arange(Q_BLOCK)
    return (q_idx[:, None] >= jnp.arange(seq)[None, :])[None, None]


def _unblock(o):
    nb, b, q, h, dv = o.shape
    return jnp.moveaxis(o, 0, 1).reshape(b, nb * q, h, dv)


def causal_softmax_attention(q, k, v):
    seq = q.shape[1]
    scale = q.shape[-1] ** -0.5

    def one_block(i):
        qi = lax.dynamic_slice_in_dim(q, i * Q_BLOCK, Q_BLOCK, axis=1)
        s = jnp.einsum('bqhd,bkhd->bhqk', qi, k).astype(jnp.float32) * scale
        p = jax.nn.softmax(jnp.where(_causal_mask(i, seq), s, NEG_INF), axis=-1)
        return jnp.einsum('bhqk,bkhd->bqhd', p.astype(v.dtype), v)

    return _unblock(lax.map(one_block, jnp.arange(seq // Q_BLOCK)))


def causal_differential_attention(q1, q2, k1, k2, v, lam):
    seq = q1.shape[1]
    scale = q1.shape[-1] ** -0.5

    def one_block(i):
        mask = _causal_mask(i, seq)
        q1i = lax.dynamic_slice_in_dim(q1, i * Q_BLOCK, Q_BLOCK, axis=1)
        q2i = lax.dynamic_slice_in_dim(q2, i * Q_BLOCK, Q_BLOCK, axis=1)
        s1 = jnp.einsum('bqhd,bkhd->bhqk', q1i, k1).astype(jnp.float32) * scale
        s2 = jnp.einsum('bqhd,bkhd->bhqk', q2i, k2).astype(jnp.float32) * scale
        p1 = jax.nn.softmax(jnp.where(mask, s1, NEG_INF), axis=-1)
        p2 = jax.nn.softmax(jnp.where(mask, s2, NEG_INF), axis=-1)
        w = p1 - lam * p2
        return jnp.einsum('bhqk,bkhd->bqhd', w.astype(v.dtype), v)

    return _unblock(lax.map(one_block, jnp.arange(seq // Q_BLOCK)))


def causal_depthwise_conv(u, w, b):
    k = w.shape[0]
    seq = u.shape[1]
    up = jnp.pad(u, ((0, 0), (k - 1, 0), (0, 0)))
    return b + sum(up[:, j:j + seq, :] * w[j] for j in range(k))


def hybrid_layer(layer, x, c, positions, w_ada, b_ada, g_norm1, w_in, b_gate, g_q_lat, w_q_up,
                 g_kv_lat, w_kv_up, g_q_mla, g_k_mla, w_o_mla, g_q_diff, g_k_diff, lam_q1, lam_k1,
                 lam_q2, lam_k2, g_sub_diff, w_o_diff, w_out, g_norm2, w_up, conv_w, conv_b, w_down):
    b_, s_, _ = x.shape
    lambda_init = 0.8 - 0.6 * math.exp(-0.3 * layer)

    mod = jnp.einsum('bd,de->be', jax.nn.silu(c), w_ada) + b_ada
    shift1, scale1, gate1, shift2, scale2, gate2 = jnp.split(mod[:, None, :], 6, axis=-1)

    h = rms_norm(x, g_norm1) * (1.0 + scale1) + shift1
    proj = jnp.einsum('bsd,de->bse', h, w_in)
    offsets = [int(o) for o in np.cumsum(IN_SPLITS)[:-1]]
    q_lat, kv_lat, k_pe, dq, dk, dv, gate_logits = jnp.split(proj, offsets, axis=-1)

    q = jnp.einsum('bsr,re->bse', rms_norm(q_lat, g_q_lat), w_q_up)
    q = q.reshape(b_, s_, MLA_HEADS, MLA_QK_DIM)
    kv = jnp.einsum('bsr,re->bse', rms_norm(kv_lat, g_kv_lat), w_kv_up)
    kv = kv.reshape(b_, s_, MLA_HEADS, MLA_NOPE_DIM + MLA_V_DIM)
    k_nope, v_mla = kv[..., :MLA_NOPE_DIM], kv[..., MLA_NOPE_DIM:]
    q_nope = rms_norm(q[..., :MLA_NOPE_DIM], g_q_mla[:MLA_NOPE_DIM])
    q_pe = rope(rms_norm(q[..., MLA_NOPE_DIM:], g_q_mla[MLA_NOPE_DIM:]), positions)
    k_nope = rms_norm(k_nope, g_k_mla[:MLA_NOPE_DIM])
    k_pe = rope(rms_norm(k_pe[:, :, None, :], g_k_mla[MLA_NOPE_DIM:]), positions)
    k_pe = jnp.broadcast_to(k_pe, (b_, s_, MLA_HEADS, MLA_ROPE_DIM))
    q_mla = jnp.concatenate([q_nope, q_pe], axis=-1)
    k_mla = jnp.concatenate([k_nope, k_pe], axis=-1)
    o_mla = causal_softmax_attention(q_mla, k_mla, v_mla).reshape(b_, s_, MIX_WIDTH_MLA)
    o_mla = jnp.einsum('bse,ed->bsd', o_mla, w_o_mla)

    dq = rope(rms_norm(dq.reshape(b_, s_, 2 * DIFF_HEADS, DIFF_HEAD_DIM), g_q_diff), positions)
    dk = rope(rms_norm(dk.reshape(b_, s_, 2 * DIFF_HEADS, DIFF_HEAD_DIM), g_k_diff), positions)
    dq = dq.reshape(b_, s_, DIFF_HEADS, 2, DIFF_HEAD_DIM)
    dk = dk.reshape(b_, s_, DIFF_HEADS, 2, DIFF_HEAD_DIM)
    dv = dv.reshape(b_, s_, DIFF_HEADS, DIFF_V_DIM)
    f32 = jnp.float32
    lam = (jnp.exp(jnp.sum(lam_q1.astype(f32) * lam_k1.astype(f32)))
           - jnp.exp(jnp.sum(lam_q2.astype(f32) * lam_k2.astype(f32))) + lambda_init)
    o_diff = causal_differential_attention(dq[..., 0, :], dq[..., 1, :], dk[..., 0, :], dk[..., 1, :], dv, lam)
    o_diff = rms_norm(o_diff, g_sub_diff) * (1.0 - lambda_init)
    o_diff = jnp.einsum('bse,ed->bsd', o_diff.reshape(b_, s_, MIX_WIDTH_DIFF), w_o_diff)

    g_a, g_b = jnp.split(jax.nn.sigmoid(gate_logits + b_gate), N_BRANCHES, axis=-1)
    mixed = g_a * o_mla + g_b * o_diff
    x = x + gate1 * jnp.einsum('bsd,de->bse', mixed, w_out)

    h2 = rms_norm(x, g_norm2) * (1.0 + scale2) + shift2
    u = jnp.einsum('bsd,df->bsf', h2, w_up)
    u = causal_depthwise_conv(u, conv_w, conv_b)
    val, gte = jnp.split(u, 2, axis=-1)
    y = jnp.einsum('bsf,fd->bsd', jax.nn.silu(gte) * val, w_down)
    return x + gate2 * y


def setup_inputs(seed: int = 0) -> dict:
    key = jax.random.key(seed)
    ks = iter(jax.random.split(key, 40))

    def w(shape, fan_in, gain=1.0):
        return jax.random.normal(next(ks), (DEPTH,) + shape, jnp.float32) * (gain * fan_in ** -0.5)

    def gain(n):
        return 1.0 + 0.02 * jax.random.normal(next(ks), (DEPTH, n), jnp.float32)

    def bias(shape, s=0.02):
        return s * jax.random.normal(next(ks), (DEPTH,) + shape, jnp.float32)

    x = jax.random.normal(next(ks), (BATCH, SEQ, D_MODEL), jnp.float32)
    c = jax.random.normal(next(ks), (BATCH, D_MODEL), jnp.float32)
    offset = jax.random.randint(next(ks), (BATCH, 1), 0, 1024, dtype=jnp.int32)
    positions = (jnp.arange(SEQ, dtype=jnp.int32)[None, :] + offset).astype(jnp.int32)
    return {
        "x": x,
        "c": c,
        "positions": positions,
        "w_ada": w((D_MODEL, 6 * D_MODEL), D_MODEL, 0.5),
        "b_ada": bias((6 * D_MODEL,)),
        "g_norm1": gain(D_MODEL),
        "w_in": w((D_MODEL, IN_WIDTH), D_MODEL),
        "b_gate": bias((N_BRANCHES * D_MODEL,)),
        "g_q_lat": gain(MLA_Q_RANK),
        "w_q_up": w((MLA_Q_RANK, MLA_HEADS * MLA_QK_DIM), MLA_Q_RANK),
        "g_kv_lat": gain(MLA_KV_RANK),
        "w_kv_up": w((MLA_KV_RANK, MLA_HEADS * (MLA_NOPE_DIM + MLA_V_DIM)), MLA_KV_RANK),
        "g_q_mla": gain(MLA_QK_DIM),
        "g_k_mla": gain(MLA_QK_DIM),
        "w_o_mla": w((MIX_WIDTH_MLA, D_MODEL), MIX_WIDTH_MLA),
        "g_q_diff": gain(DIFF_HEAD_DIM),
        "g_k_diff": gain(DIFF_HEAD_DIM),
        "lam_q1": bias((DIFF_HEAD_DIM,), 0.1),
        "lam_k1": bias((DIFF_HEAD_DIM,), 0.1),
        "lam_q2": bias((DIFF_HEAD_DIM,), 0.1),
        "lam_k2": bias((DIFF_HEAD_DIM,), 0.1),
        "g_sub_diff": gain(DIFF_V_DIM),
        "w_o_diff": w((MIX_WIDTH_DIFF, D_MODEL), MIX_WIDTH_DIFF),
        "w_out": w((D_MODEL, D_MODEL), D_MODEL),
        "g_norm2": gain(D_MODEL),
        "w_up": w((D_MODEL, 2 * D_FF), D_MODEL),
        "conv_w": w((CONV_WIDTH, 2 * D_FF), CONV_WIDTH),
        "conv_b": bias((2 * D_FF,)),
        "w_down": w((D_FF, D_MODEL), D_FF),
    }


def reference(x, c, positions, w_ada, b_ada, g_norm1, w_in, b_gate, g_q_lat, w_q_up, g_kv_lat,
              w_kv_up, g_q_mla, g_k_mla, w_o_mla, g_q_diff, g_k_diff, lam_q1, lam_k1, lam_q2, lam_k2,
              g_sub_diff, w_o_diff, w_out, g_norm2, w_up, conv_w, conv_b, w_down):
    for l in range(DEPTH):
        x = hybrid_layer(l, x, c, positions, w_ada[l], b_ada[l], g_norm1[l], w_in[l], b_gate[l],
                         g_q_lat[l], w_q_up[l], g_kv_lat[l], w_kv_up[l], g_q_mla[l], g_k_mla[l],
                         w_o_mla[l], g_q_diff[l], g_k_diff[l], lam_q1[l], lam_k1[l], lam_q2[l],
                         lam_k2[l], g_sub_diff[l], w_o_diff[l], w_out[l], g_norm2[l], w_up[l],
                         conv_w[l], conv_b[l], w_down[l])
    return x
```

```cpp
#include <hip/hip_runtime.h>
#include <hip/hip_cooperative_groups.h>
#include <cstdio>
#include <cstdint>
namespace cg = cooperative_groups;

#define LAS __attribute__((address_space(3)))
typedef unsigned short bf16_t;
typedef short bf16x8 __attribute__((ext_vector_type(8)));
typedef float f32x4 __attribute__((ext_vector_type(4)));
typedef float f32x16 __attribute__((ext_vector_type(16)));
typedef unsigned u32x4 __attribute__((ext_vector_type(4)));
typedef unsigned u32x2 __attribute__((ext_vector_type(2)));

constexpr int NB = 4, SEQ = 4096, DM = 2048, MT = NB * SEQ;
constexpr int DFF = 5632, NUP = 2 * DFF;
constexpr int R_KVL = 512, R_KPE = 768, R_DQ = 832, R_DK = 1856, R_DV = 2880, R_END = 3904;
constexpr int RP = 4096;
constexpr float EPS = 1e-6f;
constexpr float LOG2E = 1.4426950408889634f;
constexpr float QS_MLA = 0.07216878364870322f * LOG2E;
constexpr float QS_DIFF = 0.125f * LOG2E;
constexpr float LAMBDA_INIT = 0.2f;

constexpr size_t MiB = 1u << 20;
constexpr size_t WS_CTL = 0, WS_MOD = 256 * 1024, WS_PART = 1 * MiB, WS_KPE = 8 * MiB;
constexpr size_t WS_WB1 = 10 * MiB;
constexpr size_t WS_WQ = 42 * MiB, WS_WKV = 43 * MiB + 512 * 1024;
constexpr size_t WS_WOM = 45 * MiB, WS_WOD = 49 * MiB, WS_WOUT = 53 * MiB;
constexpr size_t WS_H = 61 * MiB, WS_O2 = 61 * MiB;
constexpr size_t WS_G = 125 * MiB, WS_WUP = 125 * MiB, WS_WDN = 169 * MiB;
constexpr size_t WS_DQ = 253 * MiB, WS_DK = 285 * MiB, WS_RAWQ = 317 * MiB, WS_RAWKV = 333 * MiB, WS_SSQ = 341 * MiB, WS_VM = 349 * MiB, WS_MIX = 253 * MiB, WS_ACT = 253 * MiB, WS_SIDE = 8 * MiB, WS_X1B = 429 * MiB;
constexpr size_t WS_DV = 381 * MiB, WS_QM = 413 * MiB, WS_KN = 461 * MiB;
constexpr size_t WS_END = 512 * MiB;

__device__ __forceinline__ unsigned pk_bf16(float lo, float hi) {
    typedef float f2 __attribute__((ext_vector_type(2))); typedef __bf16 b2 __attribute__((ext_vector_type(2)));
    f2 v = {lo, hi}; b2 b = __builtin_convertvector(v, b2); return __builtin_bit_cast(unsigned, b);
}
__device__ __forceinline__ float bf_lo(unsigned u) { return __uint_as_float(u << 16); }
__device__ __forceinline__ float bf_hi(unsigned u) { return __uint_as_float(u & 0xffff0000u); }
__device__ __forceinline__ void unpack8(const u32x4 r, float (&v)[8]) {
    v[0] = bf_lo(r.x); v[1] = bf_hi(r.x); v[2] = bf_lo(r.y); v[3] = bf_hi(r.y); v[4] = bf_lo(r.z); v[5] = bf_hi(r.z); v[6] = bf_lo(r.w); v[7] = bf_hi(r.w);
}
__device__ __forceinline__ u32x4 pack8(const float (&v)[8]) { u32x4 r; r.x = pk_bf16(v[0], v[1]); r.y = pk_bf16(v[2], v[3]); r.z = pk_bf16(v[4], v[5]); r.w = pk_bf16(v[6], v[7]); return r; }
__device__ __forceinline__ float sigmoidf_fast(float x) { return __builtin_amdgcn_rcpf(1.0f + __builtin_amdgcn_exp2f(-x * LOG2E)); }
__device__ __forceinline__ float wave_sum(float v) {
#pragma unroll
    for (int o = 1; o < 64; o <<= 1) v += __shfl_xor(v, o);
    return v;
}
__device__ __forceinline__ void rope_cs(int pos, int i, float& cs, float& sn) {
    const float inv_freq = __builtin_amdgcn_exp2f(-(float)i * (13.287712379549449f / 32.0f));
    const float ang = (float)pos * inv_freq;
    const float n = rintf(ang * 0.15915494309189535f);
    float r = fmaf(-n, 6.2831854820251465f, ang);
    r = fmaf(-n, -1.7484555e-7f, r);
    const float rev = r * 0.15915494309189535f;
    cs = __builtin_amdgcn_cosf(rev); sn = __builtin_amdgcn_sinf(rev);
}

__device__ __forceinline__ float rope_invf(int i) { return __builtin_amdgcn_exp2f(-(float)i * (13.287712379549449f / 32.0f)); }
__device__ __forceinline__ void rope_cs2(float posf, float invf, float& cs, float& sn) {
    const float ang = posf * invf;
    const float n = rintf(ang * 0.15915494309189535f);
    float r = fmaf(-n, 6.2831854820251465f, ang);
    r = fmaf(-n, -1.7484555e-7f, r);
    const float rev = r * 0.15915494309189535f;
    cs = __builtin_amdgcn_cosf(rev); sn = __builtin_amdgcn_sinf(rev);
}
#define EPI_LDS_BAR() do { asm volatile("s_waitcnt lgkmcnt(0)" ::: "memory"); __builtin_amdgcn_s_barrier(); asm volatile("" ::: "memory"); } while (0)

namespace pg8 {
constexpr int BM = 256, BK = 64, HALF = 128, HTB = HALF * BK * 2, STAGE_BYTES = 8 * HTB, NXCD = 8, WGM = 8;
__host__ __device__ __forceinline__ int lds_byte(int r, int c) { const int st = (r >> 4) * 2 + (c >> 5), rr = r & 15, cc = c & 31, ob = rr * 64 + cc * 2; return st * 1024 + (ob ^ (((ob >> 9) & 1) << 5)); }
__host__ __device__ __forceinline__ void stage_rc(int b, int& R, int& C) { const int st = b / 1024, sb = b % 1024, swz = sb ^ (((sb >> 9) & 1) << 5); R = (st >> 1) * 16 + swz / 64; C = (st & 1) * 32 + (swz % 64) / 2; }
__host__ __device__ __forceinline__ int perm32(int rho) { const int n = rho >> 4, i = rho & 15; return 8 * (i >> 2) + 4 * n + (i & 3); }

struct Unit { int pm, pn; };
struct Gemm { const bf16_t* A; const bf16_t* Bt; int M, N, K, lda, ldb; };

struct StaticOrder {
    int nM, nN, nwg, G, c;
    __device__ void init(int M, int N, int G_, int c_) { nM = M / BM; nN = N / BM; nwg = nM * nN; G = G_; c = c_; }
    __device__ bool next(int i, Unit& u) const {
        const long L = (long)i * G + c; if (L >= nwg) return false;
        int wgid = (int)L; { const int q = nwg / NXCD, r = nwg % NXCD, xcd = wgid % NXCD, off = wgid / NXCD; wgid = (xcd < r ? xcd * (q + 1) : r * (q + 1) + (xcd - r) * q) + off; }
        const int nig = WGM * nN, gid = wgid / nig, fm = gid * WGM, gsz = (nM - fm) < WGM ? (nM - fm) : WGM;
        u.pm = fm + ((wgid % nig) % gsz); u.pn = (wgid % nig) / gsz; return true;
    }
};


struct EpiProj {
    bf16_t* G; bf16_t* DV; bf16_t* RAWQ; bf16_t* RAWKV; float* SSQ; bf16_t* DQ; bf16_t* DK; bf16_t* KPE;
    const float* bgate; const float* gqd; const float* gkd; const float* gkm; const int* pos;
    __device__ __forceinline__ void operator()(const f32x4 (&acc)[2][2][4][2], const Unit& u, int wr, int wc, int fr, int fq) const {
        const int row0 = u.pm * BM + wr * 64 + fr; const int pn = u.pn;
        if (pn < 23) {
            const bool gate = pn < 16;
            bf16_t* const p0 = G; bf16_t* const p1 = DV; bf16_t* const p2 = RAWQ; bf16_t* const p3 = RAWKV;
            bf16_t* base = pn < 16 ? p0 : (pn < 20 ? p1 : (pn < 22 ? p2 : p3));
            const int colt = pn < 16 ? pn * BM : (pn < 20 ? (pn - 16) * BM : (pn < 22 ? (pn - 20) * BM : 0));
            const int psh = pn < 16 ? 12 : (pn < 20 ? 10 : (pn < 22 ? 9 : 8));
            const int col0 = colt + wc * 32 + 8 * fq;
            f32x4 bv[2][2];
#pragma unroll
            for (int bj = 0; bj < 2; ++bj)
#pragma unroll
                for (int n = 0; n < 2; ++n) bv[bj][n] = gate ? *(const f32x4*)(bgate + col0 + bj * HALF + 4 * n) : (f32x4){0.f, 0.f, 0.f, 0.f};
#pragma unroll
            for (int ai = 0; ai < 2; ++ai)
#pragma unroll
                for (int m = 0; m < 4; ++m) { const int row = row0 + ai * HALF + m * 16; bf16_t* rowp = base + ((size_t)row << psh) + col0; float ss = 0.f;
#pragma unroll
                    for (int bj = 0; bj < 2; ++bj) { f32x4 v0 = acc[ai][bj][m][0] + bv[bj][0], v1 = acc[ai][bj][m][1] + bv[bj][1];
                        if (gate) {
#pragma unroll
                            for (int j = 0; j < 4; ++j) { v0[j] = sigmoidf_fast(v0[j]); v1[j] = sigmoidf_fast(v1[j]); } }
                        ss += (v0[0] * v0[0] + v0[1] * v0[1]) + (v0[2] * v0[2] + v0[3] * v0[3]) + (v1[0] * v1[0] + v1[1] * v1[1]) + (v1[2] * v1[2] + v1[3] * v1[3]);
                        u32x4 w; w.x = pk_bf16(v0[0], v0[1]); w.y = pk_bf16(v0[2], v0[3]); w.z = pk_bf16(v1[0], v1[1]); w.w = pk_bf16(v1[2], v1[3]);
                        *(u32x4*)(rowp + bj * HALF) = w; }
                    if (pn >= 20) { ss += __shfl_xor(ss, 16); ss += __shfl_xor(ss, 32); if (fq == 0) SSQ[(size_t)row * 12 + (pn - 20) * 4 + wc] = ss; } }
        } else {
            const bool isq = pn < 27, iskpe = pn == 31;
            if (iskpe && wc != 0) return;
            const float* const ga = gqd; const float* const gb = gkd; const float* const gc = gkm + 128;
            const float* gp = isq ? ga : (iskpe ? gc : gb);
            bf16_t* const o0 = DQ; bf16_t* const o1 = DK; bf16_t* const o2 = KPE;
            bf16_t* ob = isq ? o0 : (iskpe ? o2 : o1);
            const int osh = iskpe ? 6 : 10, grp = iskpe ? 0 : 4 * (pn - (isq ? 23 : 27)) + wc;
            const float qs = isq ? QS_DIFF : 1.0f;
            f32x4 g0[2], g1[2]; float invf[2][4];
#pragma unroll
            for (int n = 0; n < 2; ++n) { g0[n] = *(const f32x4*)(gp + 8 * fq + 4 * n); g1[n] = *(const f32x4*)(gp + 32 + 8 * fq + 4 * n);
#pragma unroll
                for (int j = 0; j < 4; ++j) invf[n][j] = rope_invf(8 * fq + 4 * n + j); }
#pragma unroll
            for (int ai = 0; ai < 2; ++ai)
#pragma unroll
                for (int m = 0; m < 4; ++m) { const int row = row0 + ai * HALF + m * 16; const float posf = (float)pos[row];
                    float ss = 0.f;
#pragma unroll
                    for (int bj = 0; bj < 2; ++bj)
#pragma unroll
                        for (int n = 0; n < 2; ++n) { const f32x4 x = acc[ai][bj][m][n]; ss += (x[0] * x[0] + x[1] * x[1]) + (x[2] * x[2] + x[3] * x[3]); }
                    ss += __shfl_xor(ss, 16); ss += __shfl_xor(ss, 32);
                    const float rs = qs / sqrtf(ss * (1.0f / 64.0f) + EPS);
                    float lo[8], hi8[8];
#pragma unroll
                    for (int n = 0; n < 2; ++n)
#pragma unroll
                        for (int j = 0; j < 4; ++j) { float cs, sn; rope_cs2(posf, invf[n][j], cs, sn);
                            const float a = acc[ai][0][m][n][j] * g0[n][j], b = acc[ai][1][m][n][j] * g1[n][j];
                            lo[4 * n + j] = rs * (a * cs - b * sn); hi8[4 * n + j] = rs * (b * cs + a * sn); }
                    bf16_t* op = ob + ((size_t)row << osh) + 64 * grp + 8 * fq;
                    *(u32x4*)op = pack8(lo); *(u32x4*)(op + 32) = pack8(hi8); }
        }
    }
};
struct EpiQ {
    bf16_t* QM; const float* SSQ; const float* gq; const int* pos; LAS float* xch;
    __device__ __forceinline__ void operator()(const f32x4 (&acc)[2][2][4][2], const Unit& u, int wr, int wc, int fr, int fq) const {
        const int row0 = u.pm * BM + wr * 64 + fr; const int hb = u.pn / 3, tt = u.pn % 3;
#define EPI_SS16(dst) do { float ss_ = 0.f; _Pragma("unroll") for (int bj = 0; bj < 2; ++bj) _Pragma("unroll") for (int n = 0; n < 2; ++n) { const f32x4 x = acc[ai][bj][m][n]; ss_ += (x[0] * x[0] + x[1] * x[1]) + (x[2] * x[2] + x[3] * x[3]); } \
        ss_ += __shfl_xor(ss_, 16); ss_ += __shfl_xor(ss_, 32); dst = ss_; } while (0)
#define EPI_RQ(dst, row) do { const float* sp_ = SSQ + (size_t)(row) * 12; const f32x4 a_ = *(const f32x4*)sp_, b_ = *(const f32x4*)(sp_ + 4); \
        dst = 1.0f / sqrtf(((a_[0] + a_[1]) + (a_[2] + a_[3]) + (b_[0] + b_[1]) + (b_[2] + b_[3])) * (1.0f / 512.0f) + EPS); } while (0)
        if (tt < 2) {
            const int h = 4 * hb + 2 * tt + (wc >> 1), gg = wc & 1;
#pragma unroll
            for (int ai = 0; ai < 2; ++ai)
#pragma unroll
                for (int m = 0; m < 4; ++m) { float s1; EPI_SS16(s1); if (fq == 0) xch[(ai * HALF + wr * 64 + m * 16 + fr) * 4 + wc] = s1; }
            EPI_LDS_BAR();
            f32x4 g0[2], g1[2];
#pragma unroll
            for (int n = 0; n < 2; ++n) { g0[n] = *(const f32x4*)(gq + 64 * gg + 8 * fq + 4 * n); g1[n] = *(const f32x4*)(gq + 64 * gg + 32 + 8 * fq + 4 * n); }
#pragma unroll
            for (int ai = 0; ai < 2; ++ai)
#pragma unroll
                for (int m = 0; m < 4; ++m) { const int row = row0 + ai * HALF + m * 16; float r; EPI_RQ(r, row);
                    const LAS float* xr = xch + (ai * HALF + wr * 64 + m * 16 + fr) * 4 + (wc & 2);
                    const float tot = xr[0] + xr[1];
                    const float f = QS_MLA * r / sqrtf(r * r * tot * (1.0f / 128.0f) + EPS);
                    float lo[8], hi8[8];
#pragma unroll
                    for (int n = 0; n < 2; ++n)
#pragma unroll
                        for (int j = 0; j < 4; ++j) { lo[4 * n + j] = f * acc[ai][0][m][n][j] * g0[n][j]; hi8[4 * n + j] = f * acc[ai][1][m][n][j] * g1[n][j]; }
                    bf16_t* op = QM + (size_t)row * 1536 + 192 * h + 64 * gg + 8 * fq;
                    *(u32x4*)op = pack8(lo); *(u32x4*)(op + 32) = pack8(hi8); }
        } else {
            const int h = 4 * hb + wc;
            f32x4 g0[2], g1[2]; float invf[2][4];
#pragma unroll
            for (int n = 0; n < 2; ++n) { g0[n] = *(const f32x4*)(gq + 128 + 8 * fq + 4 * n); g1[n] = *(const f32x4*)(gq + 160 + 8 * fq + 4 * n);
#pragma unroll
                for (int j = 0; j < 4; ++j) invf[n][j] = rope_invf(8 * fq + 4 * n + j); }
#pragma unroll
            for (int ai = 0; ai < 2; ++ai)
#pragma unroll
                for (int m = 0; m < 4; ++m) { const int row = row0 + ai * HALF + m * 16; float r; EPI_RQ(r, row); const float posf = (float)pos[row];
                    float ss1; EPI_SS16(ss1);
                    const float f = QS_MLA * r / sqrtf(r * r * ss1 * (1.0f / 64.0f) + EPS);
                    float lo[8], hi8[8];
#pragma unroll
                    for (int n = 0; n < 2; ++n)
#pragma unroll
                        for (int j = 0; j < 4; ++j) { float cs, sn; rope_cs2(posf, invf[n][j], cs, sn);
                            const float a = acc[ai][0][m][n][j] * g0[n][j], b = acc[ai][1][m][n][j] * g1[n][j];
                            lo[4 * n + j] = f * (a * cs - b * sn); hi8[4 * n + j] = f * (b * cs + a * sn); }
                    bf16_t* op = QM + (size_t)row * 1536 + 192 * h + 128 + 8 * fq;
                    *(u32x4*)op = pack8(lo); *(u32x4*)(op + 32) = pack8(hi8); }
        }
    }
};
struct EpiKV {
    bf16_t* KN; bf16_t* VM; const float* SSQ; const float* gk; LAS float* xch;
    __device__ __forceinline__ void operator()(const f32x4 (&acc)[2][2][4][2], const Unit& u, int wr, int wc, int fr, int fq) const {
        const int row0 = u.pm * BM + wr * 64 + fr; const int h = u.pn;
#pragma unroll
        for (int ai = 0; ai < 2; ++ai)
#pragma unroll
            for (int m = 0; m < 4; ++m) { float s1; EPI_SS16(s1); if (fq == 0) xch[(ai * HALF + wr * 64 + m * 16 + fr) * 4 + wc] = s1; }
        EPI_LDS_BAR();
        const int gg = wc & 1;
        if (wc < 2) {
            f32x4 g0[2], g1[2];
#pragma unroll
            for (int n = 0; n < 2; ++n) { g0[n] = *(const f32x4*)(gk + 64 * gg + 8 * fq + 4 * n); g1[n] = *(const f32x4*)(gk + 64 * gg + 32 + 8 * fq + 4 * n); }
#pragma unroll
            for (int ai = 0; ai < 2; ++ai)
#pragma unroll
                for (int m = 0; m < 4; ++m) { const int row = row0 + ai * HALF + m * 16;
                    float r; { const f32x4 a_ = *(const f32x4*)(SSQ + (size_t)row * 12 + 8); r = 1.0f / sqrtf(((a_[0] + a_[1]) + (a_[2] + a_[3])) * (1.0f / 256.0f) + EPS); }
                    const LAS float* xr = xch + (ai * HALF + wr * 64 + m * 16 + fr) * 4 + (wc & 2);
                    const float tot = xr[0] + xr[1];
                    const float f = r / sqrtf(r * r * tot * (1.0f / 128.0f) + EPS);
                    float lo[8], hi8[8];
#pragma unroll
                    for (int n = 0; n < 2; ++n)
#pragma unroll
                        for (int j = 0; j < 4; ++j) { lo[4 * n + j] = f * acc[ai][0][m][n][j] * g0[n][j]; hi8[4 * n + j] = f * acc[ai][1][m][n][j] * g1[n][j]; }
                    bf16_t* op = KN + (size_t)row * 1024 + 128 * h + 64 * gg + 8 * fq;
                    *(u32x4*)op = pack8(lo); *(u32x4*)(op + 32) = pack8(hi8);
                    asm volatile("" ::: "memory"); }
        } else {
#pragma unroll
            for (int ai = 0; ai < 2; ++ai)
#pragma unroll
                for (int m = 0; m < 4; ++m) { const int row = row0 + ai * HALF + m * 16;
                    float r; { const f32x4 a_ = *(const f32x4*)(SSQ + (size_t)row * 12 + 8); r = 1.0f / sqrtf(((a_[0] + a_[1]) + (a_[2] + a_[3])) * (1.0f / 256.0f) + EPS); }
                    float lo[8], hi8[8];
#pragma unroll
                    for (int n = 0; n < 2; ++n)
#pragma unroll
                        for (int j = 0; j < 4; ++j) { lo[4 * n + j] = r * acc[ai][0][m][n][j]; hi8[4 * n + j] = r * acc[ai][1][m][n][j]; }
                    bf16_t* op = VM + (size_t)row * 1024 + 128 * h + 64 * gg + 8 * fq;
                    *(u32x4*)op = pack8(lo); *(u32x4*)(op + 32) = pack8(hi8);
                    asm volatile("" ::: "memory"); }
        }
    }
};
#undef EPI_SS16
#undef EPI_RQ
struct EpiPlain {
    bf16_t* O; int ldc;
    __device__ __forceinline__ void operator()(const f32x4 (&acc)[2][2][4][2], const Unit& u, int wr, int wc, int fr, int fq) const {
        const int row0 = u.pm * BM + wr * 64 + fr; const int col0 = u.pn * BM + wc * 32 + 8 * fq;
#pragma unroll
        for (int ai = 0; ai < 2; ++ai)
#pragma unroll
            for (int m = 0; m < 4; ++m) { bf16_t* rowp = O + (size_t)(row0 + ai * HALF + m * 16) * ldc + col0;
#pragma unroll
                for (int bj = 0; bj < 2; ++bj) { const f32x4 v0 = acc[ai][bj][m][0], v1 = acc[ai][bj][m][1];
                    u32x4 w; w.x = pk_bf16(v0[0], v0[1]); w.y = pk_bf16(v0[2], v0[3]); w.z = pk_bf16(v1[0], v1[1]); w.w = pk_bf16(v1[2], v1[3]);
                    *(u32x4*)(rowp + bj * HALF) = w; } }
    }
};
template <bool ADD> struct EpiGate {
    bf16_t* O; const bf16_t* Tin; const bf16_t* Gt; int gcol;
    __device__ __forceinline__ void operator()(const f32x4 (&acc)[2][2][4][2], const Unit& u, int wr, int wc, int fr, int fq) const {
        const int row0 = u.pm * BM + wr * 64 + fr; const int col0 = u.pn * BM + wc * 32 + 8 * fq;
#pragma unroll
        for (int ai = 0; ai < 2; ++ai)
#pragma unroll
            for (int m = 0; m < 4; ++m) { const size_t row = (size_t)(row0 + ai * HALF + m * 16);
#pragma unroll
                for (int bj = 0; bj < 2; ++bj) { const f32x4 v0 = acc[ai][bj][m][0], v1 = acc[ai][bj][m][1];
                    const int col = col0 + bj * HALF;
                    const u32x4 gr = *(const u32x4*)(Gt + row * RP + gcol + col); float g[8]; unpack8(gr, g);
                    float o[8];
#pragma unroll
                    for (int j = 0; j < 4; ++j) { o[j] = g[j] * v0[j]; o[4 + j] = g[4 + j] * v1[j]; }
                    if (ADD) { const u32x4 tr = *(const u32x4*)(Tin + row * DM + col); float t[8]; unpack8(tr, t);
#pragma unroll
                        for (int j = 0; j < 8; ++j) o[j] += t[j]; }
                    *(u32x4*)(O + row * DM + col) = pack8(o); } }
    }
};
struct RatioHook {
    const bf16_t* Gt;
    __device__ __forceinline__ void operator()(f32x4 (&acc)[2][2][4][2], const Unit& u, int wr, int wc, int fr, int fq) const {
        const int row0 = u.pm * BM + wr * 64 + fr; const int col0 = u.pn * BM + wc * 32 + 8 * fq;
#pragma unroll
        for (int ai = 0; ai < 2; ++ai)
#pragma unroll
            for (int m = 0; m < 4; ++m) { const bf16_t* gp = Gt + (size_t)(row0 + ai * HALF + m * 16) * RP + col0;
#pragma unroll
                for (int bj = 0; bj < 2; ++bj) {
                    const u32x4 ar = *(const u32x4*)(gp + bj * HALF), br = *(const u32x4*)(gp + 2048 + bj * HALF);
                    float a[8], b[8]; unpack8(ar, a); unpack8(br, b);
#pragma unroll
                    for (int j = 0; j < 4; ++j) { acc[ai][bj][m][0][j] *= a[j] * __builtin_amdgcn_rcpf(b[j]); acc[ai][bj][m][1][j] *= a[4 + j] * __builtin_amdgcn_rcpf(b[4 + j]); }
                    asm volatile("" : "+v"(acc[ai][bj][m][0]), "+v"(acc[ai][bj][m][1]) :: "memory"); __builtin_amdgcn_sched_barrier(0);
                } }
    }
};
struct EpiRes1 {
    const float* base; bf16_t* out; const float* gatev;
    __device__ __forceinline__ void operator()(const f32x4 (&acc)[2][2][4][2], const Unit& u, int wr, int wc, int fr, int fq) const {
        const int row0 = u.pm * BM + wr * 64 + fr; const int col0 = u.pn * BM + wc * 32 + 8 * fq;
        const float* gp = gatev + (size_t)(u.pm >> 4) * (6 * DM);
        f32x4 gv[2][2];
#pragma unroll
        for (int bj = 0; bj < 2; ++bj)
#pragma unroll
            for (int n = 0; n < 2; ++n) gv[bj][n] = *(const f32x4*)(gp + col0 + bj * HALF + 4 * n);
#pragma unroll
        for (int ai = 0; ai < 2; ++ai)
#pragma unroll
            for (int m = 0; m < 4; ++m) { const size_t off = (size_t)(row0 + ai * HALF + m * 16) * DM + col0;
#pragma unroll
                for (int bj = 0; bj < 2; ++bj) { const f32x4 b0 = *(const f32x4*)(base + off + bj * HALF), b1 = *(const f32x4*)(base + off + bj * HALF + 4);
                    const f32x4 v0 = b0 + gv[bj][0] * acc[ai][bj][m][0], v1 = b1 + gv[bj][1] * acc[ai][bj][m][1];
                    u32x4 w; w.x = pk_bf16(v0[0], v0[1]); w.y = pk_bf16(v0[2], v0[3]); w.z = pk_bf16(v1[0], v1[1]); w.w = pk_bf16(v1[2], v1[3]);
                    *(u32x4*)(out + off + bj * HALF) = w; } }
    }
};
struct EpiRes2 {
    const bf16_t* base; float* out; const float* gatev;
    __device__ __forceinline__ void operator()(const f32x4 (&acc)[2][2][4][2], const Unit& u, int wr, int wc, int fr, int fq) const {
        const int row0 = u.pm * BM + wr * 64 + fr; const int col0 = u.pn * BM + wc * 32 + 8 * fq;
        const float* gp = gatev + (size_t)(u.pm >> 4) * (6 * DM);
        f32x4 gv[2][2];
#pragma unroll
        for (int bj = 0; bj < 2; ++bj)
#pragma unroll
            for (int n = 0; n < 2; ++n) gv[bj][n] = *(const f32x4*)(gp + col0 + bj * HALF + 4 * n);
#pragma unroll
        for (int ai = 0; ai < 2; ++ai)
#pragma unroll
            for (int m = 0; m < 4; ++m) { const size_t off = (size_t)(row0 + ai * HALF + m * 16) * DM + col0;
#pragma unroll
                for (int bj = 0; bj < 2; ++bj) { const u32x4 br = *(const u32x4*)(base + off + bj * HALF); float bs[8]; unpack8(br, bs);
                    *(f32x4*)(out + off + bj * HALF) = (f32x4){bs[0], bs[1], bs[2], bs[3]} + gv[bj][0] * acc[ai][bj][m][0];
                    *(f32x4*)(out + off + bj * HALF + 4) = (f32x4){bs[4], bs[5], bs[6], bs[7]} + gv[bj][1] * acc[ai][bj][m][1]; } }
    }
};
__device__ __forceinline__ float dpp_shift1(float cur, float prev) {
    const int t = __builtin_amdgcn_update_dpp(0, __float_as_int(prev), 0x121, 0xf, 0xf, false);
    return __int_as_float(__builtin_amdgcn_update_dpp(t, __float_as_int(cur), 0x111, 0xf, 0xf, false));
}
__device__ __forceinline__ float dpp_shift2(float cur, float prev) {
    const int t = __builtin_amdgcn_update_dpp(0, __float_as_int(prev), 0x122, 0xf, 0xf, false);
    return __int_as_float(__builtin_amdgcn_update_dpp(t, __float_as_int(cur), 0x112, 0xf, 0xf, false));
}
struct EpiConv {
    bf16_t* ACT; bf16_t* SIDE; const float* cw; const float* cb;
    __device__ __forceinline__ void operator()(const f32x4 (&acc)[2][2][4][2], const Unit& u, int wr, int wc, int fr, int fq) const {
#pragma unroll
        for (int n = 0; n < 2; ++n) {
            const int ch = u.pn * 128 + wc * 32 + 8 * fq + 4 * n;
            const f32x4 w0v = *(const f32x4*)(cw + ch), w1v = *(const f32x4*)(cw + NUP + ch), w2v = *(const f32x4*)(cw + 2 * NUP + ch), bv = *(const f32x4*)(cb + ch);
            const f32x4 w0g = *(const f32x4*)(cw + DFF + ch), w1g = *(const f32x4*)(cw + NUP + DFF + ch), w2g = *(const f32x4*)(cw + 2 * NUP + DFF + ch), bg = *(const f32x4*)(cb + DFF + ch);
#pragma unroll
            for (int ai = 0; ai < 2; ++ai) {
                const int seg = u.pm * 4 + ai * 2 + wr;
#pragma unroll
                for (int m = 0; m < 4; ++m) {
                    const f32x4 uv = acc[ai][0][m][n], ug = acc[ai][1][m][n];
                    const f32x4 pv = m ? acc[ai][0][m ? m - 1 : 0][n] : (f32x4){0.f, 0.f, 0.f, 0.f};
                    const f32x4 pg = m ? acc[ai][1][m ? m - 1 : 0][n] : (f32x4){0.f, 0.f, 0.f, 0.f};
                    f32x4 a;
#pragma unroll
                    for (int j = 0; j < 4; ++j) {
                        const float s1v = dpp_shift1(uv[j], pv[j]), s2v = dpp_shift2(uv[j], pv[j]);
                        const float s1g = dpp_shift1(ug[j], pg[j]), s2g = dpp_shift2(ug[j], pg[j]);
                        const float yv = bv[j] + w2v[j] * uv[j] + w1v[j] * s1v + w0v[j] * s2v;
                        const float yg = bg[j] + w2g[j] * ug[j] + w1g[j] * s1g + w0g[j] * s2g;
                        a[j] = yv * yg * sigmoidf_fast(yg);
                    }
                    const size_t row = (size_t)seg * 64 + m * 16 + fr;
                    if (m > 0 || fr >= 2) { u32x2 w; w.x = pk_bf16(a[0], a[1]); w.y = pk_bf16(a[2], a[3]); *(u32x2*)(ACT + row * DFF + ch) = w; }
                    if ((m == 0 && fr < 2) || (m == 3 && fr >= 14)) { bf16_t* sp = SIDE + ((size_t)seg * 4 + (m == 0 ? fr : fr - 12)) * NUP + ch;
                        u32x2 sv, sg; sv.x = pk_bf16(uv[0], uv[1]); sv.y = pk_bf16(uv[2], uv[3]); sg.x = pk_bf16(ug[0], ug[1]); sg.y = pk_bf16(ug[2], ug[3]);
                        *(u32x2*)sp = sv; *(u32x2*)(sp + DFF) = sg; }
                }
            }
        }
    }
};

struct NoHook { __device__ __forceinline__ void operator()(f32x4 (&)[2][2][4][2], const Unit&, int, int, int, int) const {} };
template <class Epi, bool HOOK = false, class Hook = NoHook>
__device__ __forceinline__ void gemm_phase(LAS unsigned char* lds, const Gemm g, const StaticOrder& S, const Epi& E, const Hook& Hk = Hook()) {
    const int tid = threadIdx.x, wid = __builtin_amdgcn_readfirstlane(tid >> 6), lane = tid & 63, wr = wid >> 2, wc = wid & 3, fr = lane & 15, fq = lane >> 4;
    const int K = g.K, nt = K / BK, lda = g.lda, ldb = g.ldb ? g.ldb : g.K;
    const size_t halfoff = (size_t)K * 2;
    unsigned voffA[2], voffB[2];
#pragma unroll
    for (int i = 0; i < 2; ++i) { int R, C; stage_rc(tid * 16 + i * 8192, R, C); const int Rb = (R & ~31) + perm32(R & 31);
        voffA[i] = (unsigned)(R * lda + C) * 2u; voffB[i] = (unsigned)(Rb * ldb + C) * 2u; }
    const size_t kstep = (size_t)(BK * 2);
    const size_t hstepA = (size_t)HALF * lda * 2, hstepB = (size_t)HALF * ldb * 2;
    const size_t tstepA = 2 * hstepA, tstepB = 2 * hstepB;
    const unsigned ldsw = (unsigned)wid * 1024u;
    const int aoff = lds_byte(wr * 64 + fr, fq * 8), boff = lds_byte(wc * 32 + fr, fq * 8);
#define PG8_SA(b, h) (((b) * 2 + (h)) * HTB)
#define PG8_SB(b, h) ((4 + (b) * 2 + (h)) * HTB)
#define PG8_STAGE(bufoff, gbase, voff) do { _Pragma("unroll") for (int _i = 0; _i < 2; ++_i) \
        __builtin_amdgcn_global_load_lds((const unsigned*)((const char*)(gbase) + (voff)[_i]), (LAS unsigned*)(lds + (bufoff) + ldsw + _i * 8192), 16, 0, 0); } while (0)
#define PG8_LDA(dst, b, h) do { _Pragma("unroll") for (int m = 0; m < 4; ++m) _Pragma("unroll") for (int k = 0; k < 2; ++k) dst[m][k] = *(const LAS bf16x8*)(lds + PG8_SA(b, h) + aoff + m * 2048 + k * 1024); } while (0)
#define PG8_LDB(dst, b, h) do { _Pragma("unroll") for (int n = 0; n < 2; ++n) _Pragma("unroll") for (int k = 0; k < 2; ++k) dst[n][k] = *(const LAS bf16x8*)(lds + PG8_SB(b, h) + boff + n * 2048 + k * 1024); } while (0)
#define PG8_MMA(ai, bj, At, Bt) do { __builtin_amdgcn_s_setprio(1); _Pragma("unroll") for (int m = 0; m < 4; ++m) _Pragma("unroll") for (int n = 0; n < 2; ++n) _Pragma("unroll") for (int k = 0; k < 2; ++k) \
        acc[ai][bj][m][n] = __builtin_amdgcn_mfma_f32_16x16x32_bf16(Bt[n][k], At[m][k], acc[ai][bj][m][n], 0, 0, 0); __builtin_amdgcn_s_setprio(0); } while (0)
#define PG8_WAIT_V(n) asm volatile("s_waitcnt vmcnt(" #n ")" ::: "memory")
#define PG8_WAIT_L(n) asm volatile("s_waitcnt lgkmcnt(" #n ")" ::: "memory")
#define PG8_BAR __builtin_amdgcn_s_barrier()
#define PG8_SCHED __builtin_amdgcn_sched_barrier(0)
    Unit cur, nxt; int ui = 0;
    if (!S.next(0, cur)) return;
    f32x4 acc[2][2][4][2];
#pragma unroll
    for (int a = 0; a < 2; ++a)
#pragma unroll
        for (int b = 0; b < 2; ++b)
#pragma unroll
            for (int m = 0; m < 4; ++m)
#pragma unroll
                for (int n = 0; n < 2; ++n) acc[a][b][m][n] = (f32x4){0.f, 0.f, 0.f, 0.f};
    bf16x8 At[4][2], B0[2][2], B1[2][2];
    const char* cA = (const char*)g.A + (size_t)cur.pm * tstepA; const char* cB = (const char*)g.Bt + (size_t)cur.pn * tstepB;
    PG8_STAGE(PG8_SB(0, 0), cB, voffB); PG8_STAGE(PG8_SB(0, 1), cB + hstepB, voffB); PG8_STAGE(PG8_SA(0, 0), cA, voffA); PG8_STAGE(PG8_SA(0, 1), cA + hstepA, voffA);
    if (wr == 1) PG8_BAR;
    PG8_WAIT_V(2); PG8_BAR;
    PG8_STAGE(PG8_SB(1, 0), cB + kstep, voffB); PG8_STAGE(PG8_SA(1, 0), cA + kstep, voffA); PG8_STAGE(PG8_SB(1, 1), cB + hstepB + kstep, voffB);
    PG8_WAIT_V(6); PG8_BAR;
    for (;;) {
        const bool has_next = HOOK ? (((ui + 1) & 1) ? (nxt = cur, true) : S.next((ui + 1) >> 1, nxt)) : S.next(ui + 1, nxt);
        const size_t nho = (HOOK && ((ui + 1) & 1)) ? halfoff : 0;
        const char* nA = has_next ? (const char*)g.A + (size_t)nxt.pm * tstepA + nho : cA; const char* nB = has_next ? (const char*)g.Bt + (size_t)nxt.pn * tstepB + nho : cB;
        for (int t = 0; t < nt; t += 2) {
            const bool last = (t == nt - 2);
            const char* a1 = cA + (size_t)(t + 1) * kstep;
            const char* a2 = last ? nA : cA + (size_t)(t + 2) * kstep; const char* b2 = last ? nB : cB + (size_t)(t + 2) * kstep;
            const char* a3 = a2 + kstep; const char* b3 = b2 + kstep;
            PG8_LDB(B0, 0, 0); PG8_LDB(B1, 0, 1); PG8_SCHED; PG8_LDA(At, 0, 0); PG8_STAGE(PG8_SA(1, 1), a1 + hstepA, voffA);
            PG8_WAIT_V(8); PG8_WAIT_L(0); PG8_BAR; PG8_MMA(0, 0, At, B0); PG8_MMA(0, 1, At, B1); PG8_BAR; PG8_SCHED;
            PG8_LDA(At, 0, 1); PG8_STAGE(PG8_SB(0, 0), b2, voffB); PG8_STAGE(PG8_SB(0, 1), b2 + hstepB, voffB); PG8_STAGE(PG8_SA(0, 0), a2, voffA);
            PG8_WAIT_V(8); PG8_WAIT_L(0); PG8_BAR; PG8_MMA(1, 0, At, B0); PG8_MMA(1, 1, At, B1); PG8_BAR; PG8_SCHED;
            PG8_LDB(B0, 1, 0); PG8_LDB(B1, 1, 1); PG8_SCHED; PG8_LDA(At, 1, 0); PG8_STAGE(PG8_SA(0, 1), a2 + hstepA, voffA);
            PG8_WAIT_V(8); PG8_WAIT_L(0); PG8_BAR; PG8_MMA(0, 0, At, B0); PG8_MMA(0, 1, At, B1); PG8_BAR; PG8_SCHED;
            PG8_LDA(At, 1, 1); PG8_STAGE(PG8_SB(1, 0), b3, voffB); PG8_STAGE(PG8_SB(1, 1), b3 + hstepB, voffB); PG8_STAGE(PG8_SA(1, 0), a3, voffA);
            PG8_WAIT_V(8); PG8_WAIT_L(0); PG8_BAR; PG8_MMA(1, 0, At, B0); PG8_MMA(1, 1, At, B1); PG8_BAR; PG8_SCHED;
        }
        if (wr == 0) PG8_BAR;
        const bool half0 = HOOK && !(ui & 1);
        if (half0) Hk(acc, cur, wr, wc, fr, fq); else E(acc, cur, wr, wc, fr, fq);
        if (!has_next) break;
        { const float keep = half0 ? 1.0f : 0.0f;
#pragma unroll
        for (int a = 0; a < 2; ++a)
#pragma unroll
            for (int b = 0; b < 2; ++b)
#pragma unroll
                for (int m = 0; m < 4; ++m)
#pragma unroll
                    for (int n = 0; n < 2; ++n) { if (HOOK) acc[a][b][m][n] = acc[a][b][m][n] * keep; else acc[a][b][m][n] = (f32x4){0.f, 0.f, 0.f, 0.f}; } }
        cur = nxt; cA = nA; cB = nB; ++ui;
        if (wr == 1) PG8_BAR;
    }
    PG8_WAIT_V(0);
    PG8_BAR;
#undef PG8_SA
#undef PG8_SB
#undef PG8_STAGE
#undef PG8_LDA
#undef PG8_LDB
#undef PG8_MMA
#undef PG8_WAIT_V
#undef PG8_WAIT_L
#undef PG8_BAR
#undef PG8_SCHED
}
}

namespace att {
#define MFMA32(a, b, c) __builtin_amdgcn_mfma_f32_32x32x16_bf16((a), (b), (c), 0, 0, 0)
__device__ __forceinline__ int crow(int r, int hi) { return (r & 3) + 8 * (r >> 2) + 4 * hi; }
typedef short v4i16 __attribute__((ext_vector_type(4)));
template <int DQK> struct Cfg { static constexpr int KCH = DQK / 8, KROWB = DQK * 2, NKC = (64 * KCH) / 512, KBYTES = 64 * KROWB, VBYTES = 64 * 256, VOFF = 3 * KBYTES, TOTAL = 3 * KBYTES + 4 * VBYTES, NDMA = NKC + 2; };

template <int DQK>
__device__ __forceinline__ void attn_tiles(const bf16_t* __restrict__ Qg, int qpitch, const bf16_t* __restrict__ Kg, int kpitch, const bf16_t* __restrict__ Kpe,
                                           const bf16_t* __restrict__ Vg, int vpitch, int q0, LAS unsigned char* lds, f32x16 (&o)[4], float& l_out) {
    typedef Cfg<DQK> C;
    int tid_ = threadIdx.x; asm volatile("" : "+v"(tid_));
    const int tid = tid_, lane = tid & 63, r32 = lane & 31, hi = lane >> 5; const int w = __builtin_amdgcn_readfirstlane(tid >> 6);
    const int NT = (q0 + 256) / 64;
    const int tl = NT - 4 + (w >> 1);
    bf16x8 qf[DQK / 16];
    { const bf16_t* qrow = Qg + (size_t)(q0 + 32 * w + r32) * qpitch + 8 * hi;
#pragma unroll
      for (int ds = 0; ds < DQK / 16; ++ds) qf[ds] = *(const bf16x8*)(qrow + 16 * ds); }
    unsigned koff[C::NKC]; bool kpe_[C::NKC];
#pragma unroll
    for (int i = 0; i < C::NKC; ++i) { const int P = tid + 512 * i, kr = P / C::KCH, cp = P % C::KCH, kc = (cp & ~7) | ((cp ^ (kr >> 1)) & 7); kpe_[i] = (DQK == 192) && kc >= 16;
        koff[i] = kpe_[i] ? (unsigned)(kr * 64 + 8 * (kc - 16)) : (unsigned)(kr * kpitch + 8 * kc); }
    const unsigned voff = (unsigned)((tid >> 4) * vpitch + 8 * ((((((tid & 15) >> 1) ^ (2 * ((tid >> 4) & 3))) << 1) | (tid & 1))));
#define ATT_DMA(t) do { const bf16_t* kt_ = Kg + (size_t)(64 * (t)) * kpitch; const bf16_t* kp_ = Kpe + (size_t)(64 * (t)) * 64; const bf16_t* vt_ = Vg + (size_t)(64 * (t)) * vpitch; \
        LAS unsigned char* kb_ = lds + ((t) % 3) * C::KBYTES + w * 1024; LAS unsigned char* vb_ = lds + C::VOFF + ((t) & 3) * C::VBYTES + w * 1024; \
        _Pragma("unroll") for (int i = 0; i < C::NKC; ++i) __builtin_amdgcn_global_load_lds((const unsigned*)((kpe_[i] ? kp_ : kt_) + koff[i]), (LAS unsigned*)(kb_ + i * 8192), 16, 0, 0); \
        __builtin_amdgcn_global_load_lds((const unsigned*)(vt_ + voff), (LAS unsigned*)(vb_), 16, 0, 0); \
        __builtin_amdgcn_global_load_lds((const unsigned*)(vt_ + voff + 32 * vpitch), (LAS unsigned*)(vb_ + 8192), 16, 0, 0); } while (0)
#define ATT_WAITBAR(n) do { asm volatile("s_waitcnt vmcnt(%0)" :: "n"(n) : "memory"); __builtin_amdgcn_s_barrier(); asm volatile("" ::: "memory"); } while (0)
#pragma unroll
    for (int d = 0; d < 4; ++d)
#pragma unroll
        for (int i = 0; i < 16; ++i) o[d][i] = 0.f;
    float m_used = -INFINITY, l = 0.f;
    const unsigned hs16 = (unsigned)(((hi ^ (r32 >> 1)) & 7) * 16);
    const unsigned kbase = (unsigned)(r32 * C::KROWB);
    const int q4 = (lane & 15) >> 2;
    const unsigned vbase = (unsigned)(C::VOFF + (4 * hi + q4) * 256 + 32 * ((lane >> 4) & 1) + 8 * (lane & 3));
    unsigned xq[4];
#pragma unroll
    for (int db = 0; db < 4; ++db) xq[db] = (unsigned)((64 * db) ^ (64 * q4));
    bf16x8 pbp[4];
#pragma unroll
    for (int k = 0; k < 4; ++k) pbp[k] = (bf16x8){0, 0, 0, 0, 0, 0, 0, 0};
#define ATT_VLOAD1(ks, db) do { \
        const v4i16 lo_ = __builtin_amdgcn_ds_read_tr16_b64_v4i16((LAS v4i16*)(vp_ + (16 * (ks)) * 256 + xq[db])); \
        const v4i16 hh_ = __builtin_amdgcn_ds_read_tr16_b64_v4i16((LAS v4i16*)(vp_ + (16 * (ks) + 8) * 256 + xq[db])); \
        vf[db] = (bf16x8){lo_[0], lo_[1], lo_[2], lo_[3], hh_[0], hh_[1], hh_[2], hh_[3]}; } while (0)
#define ATT_PV_PLAIN(tp) do { const LAS unsigned char* vp_ = lds + vbase + ((tp) & 3) * C::VBYTES; bf16x8 vf[4]; \
        _Pragma("unroll") for (int db = 0; db < 4; ++db) ATT_VLOAD1(0, db); \
        _Pragma("unroll") for (int ks = 0; ks < 4; ++ks) { \
            _Pragma("unroll") for (int db = 0; db < 4; ++db) { o[db] = MFMA32(vf[db], pbp[ks], o[db]); if (ks < 3) ATT_VLOAD1(ks + 1, db); __builtin_amdgcn_sched_barrier(0); } } } while (0)
typedef float f32x2p __attribute__((ext_vector_type(2)));
#define ATT_EXP2P(S, a) do { f32x2p v_ = (f32x2p){S[a], S[(a) + 1]} + nm2; v_.x = __builtin_amdgcn_exp2f(v_.x); v_.y = __builtin_amdgcn_exp2f(v_.y); S[a] = v_.x; S[(a) + 1] = v_.y; ps2 = ps2 + v_; } while (0)
#define ATT_EXP2(k) do { if ((k) < 8) ATT_EXP2P(s0, 2 * (k)); else ATT_EXP2P(s1, 2 * ((k) - 8)); } while (0)
#define ATT_PACK() do { _Pragma("unroll") for (int s = 0; s < 2; ++s) { u32x4 a, b; \
        a.x = pk_bf16(s0[8 * s + 0], s0[8 * s + 1]); a.y = pk_bf16(s0[8 * s + 2], s0[8 * s + 3]); a.z = pk_bf16(s0[8 * s + 4], s0[8 * s + 5]); a.w = pk_bf16(s0[8 * s + 6], s0[8 * s + 7]); \
        b.x = pk_bf16(s1[8 * s + 0], s1[8 * s + 1]); b.y = pk_bf16(s1[8 * s + 2], s1[8 * s + 3]); b.z = pk_bf16(s1[8 * s + 4], s1[8 * s + 5]); b.w = pk_bf16(s1[8 * s + 6], s1[8 * s + 7]); \
        pbp[s] = __builtin_bit_cast(bf16x8, a); pbp[2 + s] = __builtin_bit_cast(bf16x8, b); } } while (0)
    ATT_DMA(0); ATT_DMA(1);
    ATT_WAITBAR(C::NDMA);
    int kst = 0;
    for (int t = 0; t < NT; ++t) {
        const bool more = (t + 2 < NT);
        if (more) ATT_DMA(t + 2);
        if (t <= tl) {
        f32x16 s0, s1;
        {
            const LAS unsigned char* kp0 = lds + kst * C::KBYTES + kbase;
#pragma unroll
            for (int i = 0; i < 16; ++i) { s0[i] = 0.f; s1[i] = 0.f; }
            bf16x8 ka[2], kb[2];
            { const unsigned a0 = hs16; ka[0] = *(const LAS bf16x8*)(kp0 + a0); kb[0] = *(const LAS bf16x8*)(kp0 + 32 * C::KROWB + a0); }
#pragma unroll
            for (int ds = 0; ds < DQK / 16; ++ds) {
                if (ds + 1 < DQK / 16) { const unsigned a1 = (unsigned)(16 * ((2 * (ds + 1)) & ~7)) + ((unsigned)(16 * ((2 * (ds + 1)) & 7)) ^ hs16);
                    ka[(ds + 1) & 1] = *(const LAS bf16x8*)(kp0 + a1); kb[(ds + 1) & 1] = *(const LAS bf16x8*)(kp0 + 32 * C::KROWB + a1); }
                s0 = MFMA32(ka[ds & 1], qf[ds], s0); s1 = MFMA32(kb[ds & 1], qf[ds], s1);
                __builtin_amdgcn_sched_barrier(0);
            }
        }
        const int jb = t - (NT - 4);
        if (jb >= 0) {
            const int qrel = 32 * w + r32 - 64 * jb - 4 * hi;
#pragma unroll
            for (int i = 0; i < 16; ++i) { if ((i & 3) + 8 * (i >> 2) > qrel) s0[i] = -INFINITY; if ((i & 3) + 8 * (i >> 2) + 32 > qrel) s1[i] = -INFINITY; }
        }
        if (t == 0) {
            float rm = fmaxf(s0[0], s1[0]);
#pragma unroll
            for (int i = 1; i < 16; ++i) rm = fmaxf(rm, fmaxf(s0[i], s1[i]));
            m_used = fmaxf(rm, __shfl_xor(rm, 32));
        }
        float ps_tile;
        {
            const LAS unsigned char* vp_ = lds + vbase + ((t ? t - 1 : 0) & 3) * C::VBYTES; bf16x8 vf[4];
            f32x2p ps2 = (f32x2p){0.f, 0.f}; const f32x2p nm2 = (f32x2p){-m_used, -m_used};
#pragma unroll
            for (int db = 0; db < 4; ++db) ATT_VLOAD1(0, db);
#pragma unroll
            for (int ks = 0; ks < 4; ++ks) {
#pragma unroll
                for (int db = 0; db < 4; ++db) { o[db] = MFMA32(vf[db], pbp[ks], o[db]); if (ks < 3) ATT_VLOAD1(ks + 1, db); ATT_EXP2(4 * ks + db); __builtin_amdgcn_sched_barrier(0); } }
            const float ps = ps2.x + ps2.y; l += ps; ps_tile = ps;
            ATT_PACK();
        }
        const float pst = ps_tile + __shfl_xor(ps_tile, 32);
        if (__any(pst > 4096.0f)) {
            const float gr = fmaxf(0.0f, __builtin_log2f(pst)); const float alpha = __builtin_amdgcn_exp2f(-gr); const float mn = m_used + gr;
            l *= alpha; m_used = mn;
#pragma unroll
            for (int d = 0; d < 4; ++d)
#pragma unroll
                for (int i = 0; i < 16; ++i) o[d][i] *= alpha;
#pragma unroll
            for (int k = 0; k < 4; ++k) { u32x4 pw = __builtin_bit_cast(u32x4, pbp[k]);
                pw.x = pk_bf16(bf_lo(pw.x) * alpha, bf_hi(pw.x) * alpha); pw.y = pk_bf16(bf_lo(pw.y) * alpha, bf_hi(pw.y) * alpha);
                pw.z = pk_bf16(bf_lo(pw.z) * alpha, bf_hi(pw.z) * alpha); pw.w = pk_bf16(bf_lo(pw.w) * alpha, bf_hi(pw.w) * alpha);
                pbp[k] = __builtin_bit_cast(bf16x8, pw); }
        }
        if (t == tl) ATT_PV_PLAIN(t);
        }
        if (more) ATT_WAITBAR(C::NDMA); else ATT_WAITBAR(0);
        kst = (kst == 2) ? 0 : kst + 1;
    }
    asm volatile("" ::: "memory"); __builtin_amdgcn_s_barrier(); asm volatile("" ::: "memory");
    l_out = l + __shfl_xor(l, 32);
#undef ATT_DMA
#undef ATT_WAITBAR
#undef ATT_VLOAD1
#undef ATT_PV_PLAIN
#undef ATT_EXP2
#undef ATT_EXP2P
#undef ATT_PACK
}
}

constexpr int NWAVES = 8, NTHREADS = 512;
constexpr int LDS_BYTES = 163840, MISC_OFF = 163584;
struct Args { const void* in[29]; float* out; unsigned char* ws; int ph_lo, ph_hi; };

struct Frame {
    LAS unsigned char* lds; int tid, lane, wave, G, gw, NGW;

};

__device__ __forceinline__ void transpose_item(const float* W, int Kp, int N, bf16_t* WT, int k0, int n0, int dst_row0, int hi_extra, const float* kgain, LAS float* scr, int lane) {
    const float* wp = W + (size_t)(k0 + (lane >> 4)) * N + n0 + 4 * (lane & 15);
    f32x4 v[16];
#pragma unroll
    for (int i = 0; i < 16; ++i) v[i] = *(const f32x4*)(wp + (size_t)(4 * i) * N);
    if (kgain) {
#pragma unroll
        for (int i = 0; i < 16; ++i) v[i] = v[i] * kgain[k0 + 4 * i + (lane >> 4)]; }
#pragma unroll
    for (int i = 0; i < 16; ++i) { LAS float* d = scr + (4 * i + (lane >> 4)) * 65 + 4 * (lane & 15); d[0] = v[i].x; d[1] = v[i].y; d[2] = v[i].z; d[3] = v[i].w; }
    asm volatile("s_waitcnt lgkmcnt(0)" ::: "memory");
    const int c = lane >> 3;
#pragma unroll
    for (int j = 0; j < 8; ++j) { const int n = (lane & 7) + 8 * j; const LAS float* s = scr + (8 * c) * 65 + n;
        u32x4 o; o.x = pk_bf16(s[0 * 65], s[1 * 65]); o.y = pk_bf16(s[2 * 65], s[3 * 65]); o.z = pk_bf16(s[4 * 65], s[5 * 65]); o.w = pk_bf16(s[6 * 65], s[7 * 65]);
        *(u32x4*)(WT + (size_t)(dst_row0 + n + (n >= 32 ? hi_extra : 0)) * Kp + k0 + 8 * c) = o; }
    asm volatile("s_waitcnt lgkmcnt(0)" ::: "memory");
}
__device__ __forceinline__ void transpose_weight(const Frame& F, const float* W, int K, int N, bf16_t* WT, int mode, int Kp = 0, const float* kgain = nullptr) {
    if (Kp == 0) Kp = K;
    LAS float* scr = (LAS float*)(F.lds + F.wave * 16640);
    const int nblk = N / 64, nitems = (K / 64) * nblk;
    for (int it = F.gw; it < nitems; it += F.NGW) {
        const int kb = it / nblk, nb = it % nblk, n0 = 64 * nb; int dst = n0;
        int hx = 0;
        if (mode == 1) {
            if (n0 >= R_END) dst = n0 - R_END;
            else if (n0 >= R_DV) dst = 4096 + (n0 - R_DV);
            else if (n0 < R_KPE) dst = 5120 + n0;
            else if (n0 < R_DQ) { dst = 256 * 31; hx = 96; }
            else { const int g = (n0 - R_DQ) >> 6; dst = 256 * (23 + (g >> 2)) + 32 * (g & 3); hx = 96; }
        }
        if (mode == 2) { const int isg = n0 >= DFF, c = n0 - isg * DFF; dst = 256 * (c >> 7) + 128 * isg + (c & 127); }
        if (mode == 3) { const int h = n0 / 192, blk = (n0 % 192) >> 6, hb = h >> 2, hq = h & 3;
            dst = blk < 2 ? 256 * (3 * hb + (hq >> 1)) + 32 * (2 * (hq & 1) + blk) : 256 * (3 * hb + 2) + 32 * hq; hx = 96; }
        if (mode == 4) { dst = 256 * (n0 >> 8) + 32 * ((n0 & 255) >> 6); hx = 96; }
        transpose_item(W, Kp, N, WT, 64 * kb, n0, dst, hx, kgain, scr, F.lane);
    }
}
__device__ __forceinline__ void modnorm_rows(const Frame& F, const float* X, const float* g, const float* shift, const float* scale, bf16_t* out) {
    for (int m = F.gw; m < MT; m += F.NGW) {
        const int b = m >> 12;
        const f32x4* xr = (const f32x4*)(X + (size_t)m * DM) + F.lane;
        f32x4 v[8]; float s = 0.f;
#pragma unroll
        for (int j = 0; j < 8; ++j) { v[j] = xr[64 * j]; s += (v[j].x * v[j].x + v[j].y * v[j].y) + (v[j].z * v[j].z + v[j].w * v[j].w); }
        const float rs = 1.0f / sqrtf(wave_sum(s) * (1.0f / DM) + EPS);
        u32x2* o8 = (u32x2*)(out + (size_t)m * DM) + F.lane;
#pragma unroll
        for (int j = 0; j < 8; ++j) { const int col = 256 * j + 4 * F.lane;
            const f32x4 gg = *(const f32x4*)(g + col), sc = *(const f32x4*)(scale + (size_t)b * 6 * DM + col), sh = *(const f32x4*)(shift + (size_t)b * 6 * DM + col);
            const f32x4 y = v[j] * rs * gg * (sc + 1.0f) + sh;
            u32x2 wv; wv.x = pk_bf16(y.x, y.y); wv.y = pk_bf16(y.z, y.w); o8[64 * j] = wv; }
    }
}
__device__ __forceinline__ void modnorm_rows_bf16(const Frame& F, const bf16_t* X, const float* g, const float* shift, const float* scale, bf16_t* out) {
    for (int m = F.gw; m < MT; m += F.NGW) {
        const int b = m >> 12;
        const u32x4* xr = (const u32x4*)(X + (size_t)m * DM) + F.lane;
        float v[4][8]; float s = 0.f;
#pragma unroll
        for (int j = 0; j < 4; ++j) { const u32x4 raw = xr[64 * j]; unpack8(raw, v[j]);
#pragma unroll
            for (int e = 0; e < 8; ++e) s += v[j][e] * v[j][e]; }
        const float rs = 1.0f / sqrtf(wave_sum(s) * (1.0f / DM) + EPS);
        u32x4* o16 = (u32x4*)(out + (size_t)m * DM) + F.lane;
#pragma unroll
        for (int j = 0; j < 4; ++j) { const int col = 512 * j + 8 * F.lane; float y[8];
#pragma unroll
            for (int hh = 0; hh < 2; ++hh) { const f32x4 gg = *(const f32x4*)(g + col + 4 * hh), sc = *(const f32x4*)(scale + (size_t)b * 6 * DM + col + 4 * hh), sh = *(const f32x4*)(shift + (size_t)b * 6 * DM + col + 4 * hh);
#pragma unroll
                for (int e = 0; e < 4; ++e) y[4 * hh + e] = v[j][4 * hh + e] * rs * gg[e] * (sc[e] + 1.0f) + sh[e]; }
            o16[64 * j] = pack8(y); }
    }
}
__device__ __forceinline__ void vtranspose(const Frame& F, const bf16_t* src, int pitch, int col0, int hstride, bf16_t* dst) {
    LAS unsigned char* T = F.lds + F.wave * 18432;
    const int lane = F.lane;
    for (int it = F.gw; it < 2048; it += F.NGW) {
        const int b = it >> 9, h = (it >> 6) & 7, sc = it & 63;
        const bf16_t* sp = src + (size_t)(b * SEQ + 64 * sc) * pitch + col0 + h * hstride;
        u32x4 rawv[16];
#pragma unroll
        for (int i = 0; i < 16; ++i) rawv[i] = *(const u32x4*)(sp + (size_t)(4 * i + (lane >> 4)) * pitch + 8 * (lane & 15));
#pragma unroll
        for (int i = 0; i < 16; ++i) { const int tok = 4 * i + (lane >> 4), ch = lane & 15;
            const u32x4 raw = rawv[i];
            const int ptok = (tok & ~12) | ((tok & 4) << 1) | ((tok & 8) >> 1);
            LAS unsigned short* tp = (LAS unsigned short*)(T + (8 * ch) * 144 + ptok * 2);
            tp[0 * 72] = (unsigned short)(raw.x & 0xffff); tp[1 * 72] = (unsigned short)(raw.x >> 16); tp[2 * 72] = (unsigned short)(raw.y & 0xffff); tp[3 * 72] = (unsigned short)(raw.y >> 16);
            tp[4 * 72] = (unsigned short)(raw.z & 0xffff); tp[5 * 72] = (unsigned short)(raw.z >> 16); tp[6 * 72] = (unsigned short)(raw.w & 0xffff); tp[7 * 72] = (unsigned short)(raw.w >> 16); }
        asm volatile("s_waitcnt lgkmcnt(0)" ::: "memory");
        bf16_t* dp = dst + (size_t)((b * 8 + h) * 128) * SEQ + 64 * sc;
#pragma unroll 4
        for (int i = 0; i < 16; ++i) { const int dv = 8 * i + (lane >> 3), c8 = lane & 7;
            const u32x4 v = *(const LAS u32x4*)(T + dv * 144 + 16 * c8);
            *(u32x4*)(dp + (size_t)dv * SEQ + 8 * c8) = v; }
        asm volatile("s_waitcnt lgkmcnt(0)" ::: "memory");
    }
}


#define XB_TMO      128
#define XB_XCNT(j)  (256  + 64 * (j))
#define XB_XSUB(j)  (1280 + 64 * (j))
#define XB_XGEN(j)  (2304 + 64 * (j))
#define XB_TOP      3328
#define XB_TOPGEN   3392
#define XCD_BAR_WORDS 3456
#define XB_SPIN_CAP (1u << 18)
__device__ __forceinline__ unsigned xb_ld(unsigned* p)              { return __hip_atomic_load(p, __ATOMIC_RELAXED, __HIP_MEMORY_SCOPE_AGENT); }
__device__ __forceinline__ unsigned xb_add(unsigned* p, unsigned v) { return __hip_atomic_fetch_add(p, v, __ATOMIC_RELAXED, __HIP_MEMORY_SCOPE_AGENT); }
__device__ __forceinline__ unsigned xb_xcc_id() { return (unsigned)__builtin_amdgcn_s_getreg((3 << 11) | 20) & 0xFu; }
#define XB_SPIN(cond, bar) do { unsigned _sp = 0; while (cond) { __builtin_amdgcn_s_sleep(1); \
    if ((++_sp & 255u) == 0u) { if (xb_ld(&(bar)[XB_TMO])) break; if (_sp > XB_SPIN_CAP) { atomicAdd(&(bar)[XB_TMO], 1u); break; } } } } while (0)
struct XcdBarrier { unsigned* bar; unsigned x; volatile LAS unsigned* st; };
__device__ __forceinline__ XcdBarrier xcd_barrier_post(unsigned* bar, volatile LAS unsigned* st) {
    XcdBarrier b; b.bar = bar; b.x = xb_xcc_id(); b.st = st;
    if (threadIdx.x == 0) (void)xb_add(&bar[XB_XCNT(b.x)], 1u);
    return b;
}
__device__ __forceinline__ void xcd_barrier_complete(unsigned* bar, unsigned x, unsigned& nloc, unsigned& nx) {
    const unsigned G = gridDim.x * gridDim.y * gridDim.z;
    unsigned sum, cnt, mine, sp = 0u;
    for (;;) {
        sum = 0u; cnt = 0u; mine = 0u;
#pragma unroll
        for (unsigned j = 0; j < 16; ++j) { const unsigned c = xb_ld(&bar[XB_XCNT(j)]); sum += c; cnt += (c > 0u) ? 1u : 0u; mine = (j == x) ? c : mine; }
        if (sum == G) break;
        __builtin_amdgcn_s_sleep(1);
        if ((++sp & 255u) == 0u) { if (xb_ld(&bar[XB_TMO])) break; if (sp > XB_SPIN_CAP) { atomicAdd(&bar[XB_TMO], 1u); break; } }
    }
    nloc = mine > 0u ? mine : 1u; nx = cnt > 0u ? cnt : 1u;
}
__device__ __forceinline__ void xcd_barrier(const XcdBarrier& b) {
    asm volatile("s_waitcnt vmcnt(0)" ::: "memory");
    __syncthreads();
    if (threadIdx.x == 0) {
        unsigned* bar = b.bar;
        __builtin_amdgcn_s_waitcnt(0);
        unsigned nloc = b.st[0], nx = b.st[1];
        if (nloc == 0u) { xcd_barrier_complete(bar, b.x, nloc, nx); b.st[0] = nloc; b.st[1] = nx; }
        const unsigned old = xb_add(&bar[XB_XSUB(b.x)], 1u);
        const unsigned gen = old / nloc;
        if (old + 1u == (gen + 1u) * nloc) {
            __builtin_amdgcn_fence(__ATOMIC_RELEASE, "agent");
            asm volatile("s_waitcnt vmcnt(0)" ::: "memory");
            const unsigned og = xb_add(&bar[XB_TOP], 1u);
            const unsigned tg = og / nx;
            if (og + 1u == (tg + 1u) * nx) xb_add(&bar[XB_TOPGEN], 1u);
            else XB_SPIN(xb_ld(&bar[XB_TOPGEN]) == tg, bar);
            __builtin_amdgcn_fence(__ATOMIC_ACQUIRE, "agent");
            xb_add(&bar[XB_XGEN(b.x)], 1u);
            asm volatile("s_waitcnt vmcnt(0)" ::: "memory");
        } else {
            XB_SPIN(xb_ld(&bar[XB_XGEN(b.x)]) == gen, bar);
            __builtin_amdgcn_fence(__ATOMIC_ACQUIRE, "agent");
            asm volatile("s_waitcnt vmcnt(0)" ::: "memory");
        }
    }
    __syncthreads();
}
constexpr int CW_BAR = 4096;
constexpr size_t CTL_ZERO_BYTES = 65536;
#define P_x ((const float*)args.in[0])
#define P_cvec ((const float*)args.in[1])
#define P_pos ((const int*)args.in[2])
#define P_w_ada ((const float*)args.in[3])
#define P_b_ada ((const float*)args.in[4])
#define P_g_norm1 ((const float*)args.in[5])
#define P_w_in ((const float*)args.in[6])
#define P_b_gate ((const float*)args.in[7])
#define P_g_q_lat ((const float*)args.in[8])
#define P_w_q_up ((const float*)args.in[9])
#define P_g_kv_lat ((const float*)args.in[10])
#define P_w_kv_up ((const float*)args.in[11])
#define P_g_q_mla ((const float*)args.in[12])
#define P_g_k_mla ((const float*)args.in[13])
#define P_w_o_mla ((const float*)args.in[14])
#define P_g_q_diff ((const float*)args.in[15])
#define P_g_k_diff ((const float*)args.in[16])
#define P_lam_q1 ((const float*)args.in[17])
#define P_lam_k1 ((const float*)args.in[18])
#define P_lam_q2 ((const float*)args.in[19])
#define P_lam_k2 ((const float*)args.in[20])
#define P_g_sub ((const float*)args.in[21])
#define P_w_o_diff ((const float*)args.in[22])
#define P_w_out ((const float*)args.in[23])
#define P_g_norm2 ((const float*)args.in[24])
#define P_w_up ((const float*)args.in[25])
#define P_conv_w ((const float*)args.in[26])
#define P_conv_b ((const float*)args.in[27])
#define P_w_down ((const float*)args.in[28])
#define P_out (args.out)
#define P_ctl ((unsigned*)(args.ws + WS_CTL))
#define P_mod ((float*)(args.ws + WS_MOD))
#define P_part ((float*)(args.ws + WS_PART))
#define P_KPE ((bf16_t*)(args.ws + WS_KPE))
#define P_WB1 ((bf16_t*)(args.ws + WS_WB1))
#define P_WQ ((bf16_t*)(args.ws + WS_WQ))
#define P_WKV ((bf16_t*)(args.ws + WS_WKV))
#define P_WOM ((bf16_t*)(args.ws + WS_WOM))
#define P_WOUT ((bf16_t*)(args.ws + WS_WOUT))
#define P_Hb ((bf16_t*)(args.ws + WS_H))
#define P_DQ ((bf16_t*)(args.ws + WS_DQ))
#define P_DK ((bf16_t*)(args.ws + WS_DK))
#define P_MIX ((bf16_t*)(args.ws + WS_MIX))
#define P_Gb ((bf16_t*)(args.ws + WS_G))
#define P_WUP ((bf16_t*)(args.ws + WS_WUP))
#define P_WDN ((bf16_t*)(args.ws + WS_WDN))
#define P_O2 ((bf16_t*)(args.ws + WS_O2))
#define P_ACT ((bf16_t*)(args.ws + WS_ACT))
#define P_SIDE ((bf16_t*)(args.ws + WS_SIDE))
#define P_X1B ((bf16_t*)(args.ws + WS_X1B))
#define P_DV ((bf16_t*)(args.ws + WS_DV))
#define P_QM ((bf16_t*)(args.ws + WS_QM))
#define P_KN ((bf16_t*)(args.ws + WS_KN))
#define P_RAWQ ((bf16_t*)(args.ws + WS_RAWQ))
#define P_RAWKV ((bf16_t*)(args.ws + WS_RAWKV))
#define P_SSQ ((float*)(args.ws + WS_SSQ))
#define P_VM ((bf16_t*)(args.ws + WS_VM))
__global__ void __launch_bounds__(NTHREADS, 2) fwd_kernel(Args args) {
    extern __shared__ __attribute__((aligned(16))) unsigned char lds_raw[];
    cg::grid_group grid = cg::this_grid();
    Frame F;
    F.lds = (LAS unsigned char*)lds_raw; F.tid = threadIdx.x; F.lane = F.tid & 63; F.wave = __builtin_amdgcn_readfirstlane(F.tid >> 6);
    F.G = gridDim.x; F.gw = blockIdx.x * NWAVES + F.wave; F.NGW = F.G * NWAVES;
    volatile LAS int* misc = (volatile LAS int*)(F.lds + MISC_OFF);
    if (F.tid < 32) misc[F.tid] = 0;
    __syncthreads();
    const XcdBarrier bar = xcd_barrier_post(P_ctl + CW_BAR, (volatile LAS unsigned*)(misc + 8));
    if (args.ph_lo < 0) grid.sync();

    const int lo = args.ph_lo, hi_ = args.ph_hi;
#ifndef PHASE_MASK
#define PHASE_MASK 0x7fff
#endif
#define IN(k) (((PHASE_MASK >> (k)) & 1) && lo <= (k) && (k) < hi_)
#define SEAM(k) do { if (IN(k) && IN((k) + 1)) xcd_barrier(bar); } while (0)
#ifndef REP_MASK
#define REP_MASK 0
#endif
#define REPS(k) ((((REP_MASK) >> (k)) & 1) ? 2 : 1)
#define PHASE(k) if (IN(k)) for (int rep = 0; rep < REPS(k); ++rep, (rep < REPS(k) ? xcd_barrier(bar) : (void)0))

    PHASE(0) {
        for (int it = blockIdx.x; it < 192; it += F.G) {
            const int e = 64 * it + F.lane, d0 = 256 * F.wave;
            float a0 = 0.f, a1 = 0.f, a2 = 0.f, a3 = 0.f;
#pragma unroll 1
            for (int dq = 0; dq < 4; ++dq) {
                float sl[4];
#pragma unroll
                for (int b = 0; b < 4; ++b) { const float cv = P_cvec[b * DM + d0 + 64 * dq + F.lane]; sl[b] = cv * sigmoidf_fast(cv); }
#pragma unroll 16
                for (int dd = 0; dd < 64; ++dd) {
                    const float wv = P_w_ada[(size_t)(d0 + 64 * dq + dd) * (6 * DM) + e];
                    a0 += wv * __shfl(sl[0], dd); a1 += wv * __shfl(sl[1], dd); a2 += wv * __shfl(sl[2], dd); a3 += wv * __shfl(sl[3], dd);
                }
            }
            LAS float* red = (LAS float*)(F.lds + 133120);
            __syncthreads();
            red[(F.wave * 4 + 0) * 64 + F.lane] = a0; red[(F.wave * 4 + 1) * 64 + F.lane] = a1; red[(F.wave * 4 + 2) * 64 + F.lane] = a2; red[(F.wave * 4 + 3) * 64 + F.lane] = a3;
            __syncthreads();
            if (F.wave < 4) { float sacc = P_b_ada[e];
#pragma unroll
                for (int w8 = 0; w8 < 8; ++w8) sacc += red[(w8 * 4 + F.wave) * 64 + F.lane];
                P_mod[F.wave * (6 * DM) + e] = sacc; }
        }
        transpose_weight(F, P_w_in, DM, 8000, P_WB1, 1);
        transpose_weight(F, P_w_q_up, 512, 1536, P_WQ, 3, 0, P_g_q_lat);
        transpose_weight(F, P_w_kv_up, 256, 2048, P_WKV, 4, 0, P_g_kv_lat);
        transpose_weight(F, P_w_o_mla, 1024, DM, P_WOM, 0, 2048);
        transpose_weight(F, P_w_o_diff, 1024, DM, P_WOM + 1024, 0, 2048);
        transpose_weight(F, P_w_out, DM, DM, P_WOUT, 0);
    }
    SEAM(0);
    PHASE(2) modnorm_rows(F, P_x, P_g_norm1, P_mod + 0 * DM, P_mod + 1 * DM, P_Hb);
    SEAM(2);
    PHASE(3) {
        pg8::Gemm g{P_Hb, P_WB1, MT, 8192, DM, DM, 0}; pg8::StaticOrder S; S.init(MT, 8192, F.G, (int)blockIdx.x);
        pg8::EpiProj E{P_Gb, P_DV, P_RAWQ, P_RAWKV, P_SSQ, P_DQ, P_DK, P_KPE, P_b_gate, P_g_q_diff, P_g_k_diff, P_g_k_mla, P_pos};
        pg8::gemm_phase(F.lds, g, S, E);
    }
    SEAM(3);
    PHASE(5) {
        LAS float* xch = (LAS float*)(F.lds + 133120);
        { pg8::Gemm g{P_RAWQ, P_WQ, MT, 1536, 512, 512, 0}; pg8::StaticOrder S; S.init(MT, 1536, F.G, (int)blockIdx.x); pg8::EpiQ E{P_QM, P_SSQ, P_g_q_mla, P_pos, xch}; pg8::gemm_phase(F.lds, g, S, E); }
        { pg8::Gemm g{P_RAWKV, P_WKV, MT, 2048, 256, 256, 0}; pg8::StaticOrder S; S.init(MT, 2048, F.G, (int)blockIdx.x); pg8::EpiKV E{P_KN, P_VM, P_SSQ, P_g_k_mla, xch}; pg8::gemm_phase(F.lds, g, S, E); }
    }
    SEAM(5);
    PHASE(7) {
        float lam;
        { const float a = wave_sum(P_lam_q1[F.lane] * P_lam_k1[F.lane]), b = wave_sum(P_lam_q2[F.lane] * P_lam_k2[F.lane]); lam = expf(a) - expf(b) + LAMBDA_INIT; }
        const int lane = F.lane, r32 = lane & 31, hi = lane >> 5, w = F.wave;
        for (;;) {
            if (F.tid == 0) misc[0] = (int)__hip_atomic_fetch_add(P_ctl, 1u, __ATOMIC_RELAXED, __HIP_MEMORY_SCOPE_AGENT);
            __syncthreads();
            const int uidx = misc[0] - rep * (1024 + F.G);
            __syncthreads();
            if (uidx >= 1024) break;
            const int qb = 15 - (uidx >> 6), within = uidx & 63, kind = within >> 5, bh = within & 31, b = bh >> 3, h = bh & 7;
            const int q0 = 256 * qb; const size_t row0 = (size_t)b * SEQ; const size_t mrow = row0 + q0 + 32 * w + r32;
            f32x16 o[4]; float l;
            if (kind == 1) {
                att::attn_tiles<192>(P_QM + row0 * 1536 + 192 * h, 1536, P_KN + row0 * 1024 + 128 * h, 1024, P_KPE + row0 * 64, P_VM + row0 * 1024 + 128 * h, 1024, q0, F.lds, o, l);
                const float inv = 1.0f / l;
#pragma unroll
                for (int db = 0; db < 4; ++db)
#pragma unroll
                    for (int g = 0; g < 4; ++g) { u32x2 wv; wv.x = pk_bf16(o[db][4 * g] * inv, o[db][4 * g + 1] * inv); wv.y = pk_bf16(o[db][4 * g + 2] * inv, o[db][4 * g + 3] * inv);
                        *(u32x2*)(P_O2 + mrow * DM + 128 * h + 32 * db + 8 * g + 4 * hi) = wv; }
            } else {
                const bf16_t* Vt = P_DV + row0 * 1024 + 128 * h;
                att::attn_tiles<64>(P_DQ + row0 * 1024 + 128 * h, 1024, P_DK + row0 * 1024 + 128 * h, 1024, nullptr, Vt, 1024, q0, F.lds, o, l);
                LAS unsigned* stash = (LAS unsigned*)(F.lds + att::Cfg<64>::TOTAL) + F.tid;
                { const float inv = 1.0f / l;
#pragma unroll
                  for (int db = 0; db < 4; ++db)
#pragma unroll
                      for (int g = 0; g < 4; ++g) { stash[(db * 8 + g * 2) * 512] = pk_bf16(o[db][4 * g] * inv, o[db][4 * g + 1] * inv); stash[(db * 8 + g * 2 + 1) * 512] = pk_bf16(o[db][4 * g + 2] * inv, o[db][4 * g + 3] * inv); } }
                att::attn_tiles<64>(P_DQ + row0 * 1024 + 128 * h + 64, 1024, P_DK + row0 * 1024 + 128 * h + 64, 1024, nullptr, Vt, 1024, q0, F.lds, o, l);
                const float inv2 = lam / l; float ss = 0.f;
#pragma unroll
                for (int db = 0; db < 4; ++db)
#pragma unroll
                    for (int g = 0; g < 4; ++g) {
                        const unsigned sx = stash[(db * 8 + g * 2) * 512], sy = stash[(db * 8 + g * 2 + 1) * 512];
                        const float d0 = bf_lo(sx) - inv2 * o[db][4 * g], d1 = bf_hi(sx) - inv2 * o[db][4 * g + 1];
                        const float d2 = bf_lo(sy) - inv2 * o[db][4 * g + 2], d3 = bf_hi(sy) - inv2 * o[db][4 * g + 3];
                        o[db][4 * g] = d0; o[db][4 * g + 1] = d1; o[db][4 * g + 2] = d2; o[db][4 * g + 3] = d3; ss += (d0 * d0 + d1 * d1) + (d2 * d2 + d3 * d3); }
                ss += __shfl_xor(ss, 32);
                const float rs = (1.0f - LAMBDA_INIT) / sqrtf(ss * (1.0f / 128.0f) + EPS);
#pragma unroll
                for (int db = 0; db < 4; ++db)
#pragma unroll
                    for (int g = 0; g < 4; ++g) { const int dv = 32 * db + 8 * g + 4 * hi; const f32x4 gs = *(const f32x4*)(P_g_sub + dv);
                        u32x2 wv; wv.x = pk_bf16(o[db][4 * g] * rs * gs.x, o[db][4 * g + 1] * rs * gs.y); wv.y = pk_bf16(o[db][4 * g + 2] * rs * gs.z, o[db][4 * g + 3] * rs * gs.w);
                        *(u32x2*)(P_O2 + mrow * DM + 1024 + 128 * h + dv) = wv; }
            }
        }
    }
    SEAM(7);
    PHASE(8) { pg8::Gemm g{P_O2, P_WOM, MT, DM, 1024, 2048, 2048}; pg8::StaticOrder S; S.init(MT, DM, F.G, (int)blockIdx.x); pg8::EpiGate<false> E{P_MIX, nullptr, P_Gb, 2048}; pg8::RatioHook Hk{P_Gb};
        pg8::gemm_phase<pg8::EpiGate<false>, true, pg8::RatioHook>(F.lds, g, S, E, Hk); }
    SEAM(8);
    PHASE(10) { pg8::Gemm g{P_MIX, P_WOUT, MT, DM, DM, DM, 0}; pg8::StaticOrder S; S.init(MT, DM, F.G, (int)blockIdx.x); pg8::EpiRes1 E{P_x, P_X1B, P_mod + 2 * DM}; pg8::gemm_phase(F.lds, g, S, E); }
    SEAM(10);
    PHASE(11) {
        modnorm_rows_bf16(F, P_X1B, P_g_norm2, P_mod + 3 * DM, P_mod + 4 * DM, P_Hb);
        transpose_weight(F, P_w_up, DM, NUP, P_WUP, 2);
        transpose_weight(F, P_w_down, DFF, DM, P_WDN, 0);
    }
    SEAM(11);
    PHASE(12) { pg8::Gemm g{P_Hb, P_WUP, MT, NUP, DM, DM, 0}; pg8::StaticOrder S; S.init(MT, NUP, F.G, (int)blockIdx.x); pg8::EpiConv E{P_ACT, P_SIDE, P_conv_w, P_conv_b}; pg8::gemm_phase(F.lds, g, S, E); }
    SEAM(12);
    PHASE(13) {
        for (int i = blockIdx.x * NTHREADS + F.tid; i < 256 * 2 * (DFF / 4); i += F.G * NTHREADS) {
            const int c = (i % (DFF / 4)) * 4, j = (i / (DFF / 4)) & 1, seg = i / (2 * (DFF / 4));
            const bool hasprev = (seg & 63) != 0;
            const bf16_t* sp = P_SIDE + (size_t)seg * 4 * NUP; const bf16_t* pp = P_SIDE + (size_t)(seg - 1) * 4 * NUP;
#define LD4B(p) ({ const u32x2 r_ = *(const u32x2*)(p); (f32x4){bf_lo(r_.x), bf_hi(r_.x), bf_lo(r_.y), bf_hi(r_.y)}; })
            const f32x4 z = (f32x4){0.f, 0.f, 0.f, 0.f};
            f32x4 a;
            f32x4 y[2];
#pragma unroll
            for (int hlf = 0; hlf < 2; ++hlf) {
                const int cc = c + hlf * DFF;
                const f32x4 ut = LD4B(sp + (size_t)j * NUP + cc);
                const f32x4 u1 = j ? LD4B(sp + cc) : (hasprev ? LD4B(pp + (size_t)3 * NUP + cc) : z);
                const f32x4 u2 = hasprev ? LD4B(pp + (size_t)(j ? 3 : 2) * NUP + cc) : z;
                const f32x4 w0 = *(const f32x4*)(P_conv_w + cc), w1 = *(const f32x4*)(P_conv_w + NUP + cc), w2 = *(const f32x4*)(P_conv_w + 2 * NUP + cc), bb = *(const f32x4*)(P_conv_b + cc);
                y[hlf] = bb + w2 * ut + w1 * u1 + w0 * u2;
            }
#pragma unroll
            for (int q = 0; q < 4; ++q) a[q] = y[0][q] * y[1][q] * sigmoidf_fast(y[1][q]);
            u32x2 wv; wv.x = pk_bf16(a[0], a[1]); wv.y = pk_bf16(a[2], a[3]);
            *(u32x2*)(P_ACT + ((size_t)seg * 64 + j) * DFF + c) = wv;
        }
    }
    SEAM(13);
    PHASE(14) { pg8::Gemm g{P_ACT, P_WDN, MT, DM, DFF, DFF, 0}; pg8::StaticOrder S; S.init(MT, DM, F.G, (int)blockIdx.x); pg8::EpiRes2 E{P_X1B, P_out, P_mod + 5 * DM}; pg8::gemm_phase(F.lds, g, S, E); }
#undef IN
#undef SEAM
}

#undef P_x
#undef P_cvec
#undef P_pos
#undef P_w_ada
#undef P_b_ada
#undef P_g_norm1
#undef P_w_in
#undef P_b_gate
#undef P_g_q_lat
#undef P_w_q_up
#undef P_g_kv_lat
#undef P_w_kv_up
#undef P_g_q_mla
#undef P_g_k_mla
#undef P_w_o_mla
#undef P_g_q_diff
#undef P_g_k_diff
#undef P_lam_q1
#undef P_lam_k1
#undef P_lam_q2
#undef P_lam_k2
#undef P_g_sub
#undef P_w_o_diff
#undef P_w_out
#undef P_g_norm2
#undef P_w_up
#undef P_conv_w
#undef P_conv_b
#undef P_w_down
#undef P_out
#undef P_ctl
#undef P_mod
#undef P_part
#undef P_KPE
#undef P_WB1
#undef P_WQ
#undef P_WKV
#undef P_WOM
#undef P_WOUT
#undef P_Hb
#undef P_DQ
#undef P_DK
#undef P_MIX
#undef P_Gb
#undef P_WUP
#undef P_WDN
#undef P_O2
#undef P_ACT
#undef P_SIDE
#undef P_X1B
#undef P_DV
#undef P_QM
#undef P_KN
#undef P_RAWQ
#undef P_RAWKV
#undef P_SSQ
#undef P_VM
#ifndef N_LAUNCHES
#define N_LAUNCHES 1
#endif
constexpr int N_PHASES = 15;

extern "C" void kernel_launch(void* const* d_in, const int* in_sizes, int n_in, void* d_out, int out_size, void* d_ws, size_t ws_size, hipStream_t stream) {
    static int grid = 0;
    if (grid == 0) {
        if (n_in != 29 || in_sizes[0] != MT * DM || out_size != MT * DM || ws_size < WS_END) {
            fprintf(stderr, "kernel_launch: unexpected shapes: n_in %d in0 %d out %d ws %zu (need %zu)\n", n_in, n_in > 0 ? in_sizes[0] : -1, out_size, ws_size, (size_t)WS_END); grid = -1; return; }
        int dev = 0, cus = 0, per_cu = 0;
        (void)hipGetDevice(&dev); (void)hipDeviceGetAttribute(&cus, hipDeviceAttributeMultiprocessorCount, dev);
        if (hipFuncSetAttribute((const void*)fwd_kernel, hipFuncAttributeMaxDynamicSharedMemorySize, LDS_BYTES) != hipSuccess) { fprintf(stderr, "kernel_launch: hipFuncSetAttribute failed\n"); grid = -1; return; }
        if (hipOccupancyMaxActiveBlocksPerMultiprocessor(&per_cu, (const void*)fwd_kernel, NTHREADS, LDS_BYTES) != hipSuccess || per_cu < 1) { fprintf(stderr, "kernel_launch: occupancy query says %d blocks per CU\n", per_cu); per_cu = 1; }
        (void)hipGetLastError();
        grid = cus * 1;
        if (grid <= 0) grid = 256;
    }
    if (grid < 0) return;
    if (hipMemsetAsync((char*)d_ws + WS_CTL, 0, CTL_ZERO_BYTES, stream) != hipSuccess) { fprintf(stderr, "kernel_launch: hipMemsetAsync failed\n"); return; }
    Args a{};
    for (int i = 0; i < 29; ++i) a.in[i] = d_in[i];
    a.out = (float*)d_out; a.ws = (unsigned char*)d_ws;
#if N_LAUNCHES == 1
    a.ph_lo = 0; a.ph_hi = N_PHASES;
    void* kargs[] = {&a};
    hipError_t e = hipLaunchCooperativeKernel((const void*)fwd_kernel, dim3(grid), dim3(NTHREADS), kargs, LDS_BYTES, stream);
    if (e != hipSuccess) fprintf(stderr, "kernel_launch: cooperative launch failed: %s (grid %d)\n", hipGetErrorString(e), grid);
#else
    for (int p = 0; p < N_PHASES; ++p) {
        a.ph_lo = p; a.ph_hi = p + 1;
        void* kargs[] = {&a};
        hipError_t e = hipLaunchCooperativeKernel((const void*)fwd_kernel, dim3(grid), dim3(NTHREADS), kargs, LDS_BYTES, stream);
        if (e != hipSuccess) { fprintf(stderr, "kernel_launch: launch %d failed: %s\n", p, hipGetErrorString(e)); break; }
    }
#endif
}
```

```cpp
#include <hip/hip_runtime.h>
#include <hip/hip_cooperative_groups.h>
#include <cstdio>
#include <cstdint>
namespace cg = cooperative_groups;

#define LAS __attribute__((address_space(3)))
typedef unsigned short bf16_t;
typedef short bf16x8 __attribute__((ext_vector_type(8)));
typedef float f32x4 __attribute__((ext_vector_type(4)));
typedef float f32x16 __attribute__((ext_vector_type(16)));
typedef unsigned u32x4 __attribute__((ext_vector_type(4)));
typedef unsigned u32x2 __attribute__((ext_vector_type(2)));

constexpr int NB = 4, SEQ = 4096, DM = 2048, MT = NB * SEQ;
constexpr int DFF = 5632, NUP = 2 * DFF;
constexpr int R_KVL = 512, R_KPE = 768, R_DQ = 832, R_DK = 1856, R_DV = 2880, R_END = 3904;
constexpr int RP = 4096;
constexpr float EPS = 1e-6f;
constexpr float LOG2E = 1.4426950408889634f;
constexpr float QS_MLA = 0.07216878364870322f * LOG2E;
constexpr float QS_DIFF = 0.125f * LOG2E;
constexpr float LAMBDA_INIT = 0.2f;

constexpr size_t MiB = 1u << 20;
constexpr size_t WS_CTL = 0, WS_MOD = 256 * 1024, WS_PART = 1 * MiB, WS_KPE = 8 * MiB;
constexpr size_t WS_WB1 = 10 * MiB;
constexpr size_t WS_WQ = 42 * MiB, WS_WKV = 43 * MiB + 512 * 1024;
constexpr size_t WS_WOM = 45 * MiB, WS_WOD = 49 * MiB, WS_WOUT = 53 * MiB;
constexpr size_t WS_H = 61 * MiB, WS_O2 = 61 * MiB;
constexpr size_t WS_G = 125 * MiB, WS_WUP = 125 * MiB, WS_WDN = 169 * MiB;
constexpr size_t WS_DQ = 253 * MiB, WS_DK = 285 * MiB, WS_RAWQ = 317 * MiB, WS_RAWKV = 333 * MiB, WS_SSQ = 341 * MiB, WS_VM = 349 * MiB, WS_MIX = 253 * MiB, WS_ACT = 253 * MiB, WS_SIDE = 8 * MiB, WS_X1B = 429 * MiB;
constexpr size_t WS_DV = 381 * MiB, WS_QM = 413 * MiB, WS_KN = 461 * MiB;
constexpr size_t WS_END = 512 * MiB;

__device__ __forceinline__ unsigned pk_bf16(float lo, float hi) {
    typedef float f2 __attribute__((ext_vector_type(2))); typedef __bf16 b2 __attribute__((ext_vector_type(2)));
    f2 v = {lo, hi}; b2 b = __builtin_convertvector(v, b2); return __builtin_bit_cast(unsigned, b);
}
__device__ __forceinline__ float bf_lo(unsigned u) { return __uint_as_float(u << 16); }
__device__ __forceinline__ float bf_hi(unsigned u) { return __uint_as_float(u & 0xffff0000u); }
__device__ __forceinline__ void unpack8(const u32x4 r, float (&v)[8]) {
    v[0] = bf_lo(r.x); v[1] = bf_hi(r.x); v[2] = bf_lo(r.y); v[3] = bf_hi(r.y); v[4] = bf_lo(r.z); v[5] = bf_hi(r.z); v[6] = bf_lo(r.w); v[7] = bf_hi(r.w);
}
__device__ __forceinline__ u32x4 pack8(const float (&v)[8]) { u32x4 r; r.x = pk_bf16(v[0], v[1]); r.y = pk_bf16(v[2], v[3]); r.z = pk_bf16(v[4], v[5]); r.w = pk_bf16(v[6], v[7]); return r; }
__device__ __forceinline__ float sigmoidf_fast(float x) { return __builtin_amdgcn_rcpf(1.0f + __builtin_amdgcn_exp2f(-x * LOG2E)); }
__device__ __forceinline__ float wave_sum(float v) {
#pragma unroll
    for (int o = 1; o < 64; o <<= 1) v += __shfl_xor(v, o);
    return v;
}
__device__ __forceinline__ void rope_cs(int pos, int i, float& cs, float& sn) {
    const float inv_freq = __builtin_amdgcn_exp2f(-(float)i * (13.287712379549449f / 32.0f));
    const float ang = (float)pos * inv_freq;
    const float n = rintf(ang * 0.15915494309189535f);
    float r = fmaf(-n, 6.2831854820251465f, ang);
    r = fmaf(-n, -1.7484555e-7f, r);
    const float rev = r * 0.15915494309189535f;
    cs = __builtin_amdgcn_cosf(rev); sn = __builtin_amdgcn_sinf(rev);
}

__device__ __forceinline__ float rope_invf(int i) { return __builtin_amdgcn_exp2f(-(float)i * (13.287712379549449f / 32.0f)); }
__device__ __forceinline__ void rope_cs2(float posf, float invf, float& cs, float& sn) {
    const float ang = posf * invf;
    const float n = rintf(ang * 0.15915494309189535f);
    float r = fmaf(-n, 6.2831854820251465f, ang);
    r = fmaf(-n, -1.7484555e-7f, r);
    const float rev = r * 0.15915494309189535f;
    cs = __builtin_amdgcn_cosf(rev); sn = __builtin_amdgcn_sinf(rev);
}
#define EPI_LDS_BAR() do { asm volatile("s_waitcnt lgkmcnt(0)" ::: "memory"); __builtin_amdgcn_s_barrier(); asm volatile("" ::: "memory"); } while (0)

namespace pg8 {
constexpr int BM = 256, BK = 64, HALF = 128, HTB = HALF * BK * 2, STAGE_BYTES = 8 * HTB, NXCD = 8, WGM = 8;
__host__ __device__ __forceinline__ int lds_byte(int r, int c) { const int st = (r >> 4) * 2 + (c >> 5), rr = r & 15, cc = c & 31, ob = rr * 64 + cc * 2; return st * 1024 + (ob ^ (((ob >> 9) & 1) << 5)); }
__host__ __device__ __forceinline__ void stage_rc(int b, int& R, int& C) { const int st = b / 1024, sb = b % 1024, swz = sb ^ (((sb >> 9) & 1) << 5); R = (st >> 1) * 16 + swz / 64; C = (st & 1) * 32 + (swz % 64) / 2; }
__host__ __device__ __forceinline__ int perm32(int rho) { const int n = rho >> 4, i = rho & 15; return 8 * (i >> 2) + 4 * n + (i & 3); }

struct Unit { int pm, pn; };
struct Gemm { const bf16_t* A; const bf16_t* Bt; int M, N, K, lda, ldb; };

struct StaticOrder {
    int nM, nN, nwg, G, c;
    __device__ void init(int M, int N, int G_, int c_) { nM = M / BM; nN = N / BM; nwg = nM * nN; G = G_; c = c_; }
    __device__ bool next(int i, Unit& u) const {
        const long L = (long)i * G + c; if (L >= nwg) return false;
        int wgid = (int)L; { const int q = nwg / NXCD, r = nwg % NXCD, xcd = wgid % NXCD, off = wgid / NXCD; wgid = (xcd < r ? xcd * (q + 1) : r * (q + 1) + (xcd - r) * q) + off; }
        const int nig = WGM * nN, gid = wgid / nig, fm = gid * WGM, gsz = (nM - fm) < WGM ? (nM - fm) : WGM;
        u.pm = fm + ((wgid % nig) % gsz); u.pn = (wgid % nig) / gsz; return true;
    }
};


struct EpiProj {
    bf16_t* G;
    const float* bgate; const float* gqd; const float* gkd; const float* gkm; const int* pos;
    __device__ __forceinline__ void operator()(const f32x4 (&acc)[2][2][4][2], const Unit& u, int wr, int wc, int fr, int fq) const {
        const int row0 = u.pm * BM + wr * 64 + fr; const int pn = u.pn;
        unsigned char* const wsb = (unsigned char*)G - WS_G;
        bf16_t* const DV = (bf16_t*)(wsb + WS_DV); bf16_t* const RAWQ = (bf16_t*)(wsb + WS_RAWQ); bf16_t* const RAWKV = (bf16_t*)(wsb + WS_RAWKV); float* const SSQ = (float*)(wsb + WS_SSQ);
        bf16_t* const DQ = (bf16_t*)(wsb + WS_DQ); bf16_t* const DK = (bf16_t*)(wsb + WS_DK); bf16_t* const KPE = (bf16_t*)(wsb + WS_KPE);
        if (pn < 16) {
            const int ch0 = pn * 128 + wc * 32 + 8 * fq;
            bf16_t* const gr_ = G;
#pragma unroll
            for (int ai = 0; ai < 2; ++ai)
#pragma unroll
                for (int m = 0; m < 4; ++m) { const size_t off = (size_t)(row0 + ai * HALF + m * 16) * 2048 + ch0; float rr[8], gg[8];
#pragma unroll
                    for (int n = 0; n < 2; ++n) { const f32x4 ba = *(const f32x4*)(bgate + ch0 + 4 * n), bb = *(const f32x4*)(bgate + 2048 + ch0 + 4 * n);
#pragma unroll
                        for (int j = 0; j < 4; ++j) { const float ea = __builtin_amdgcn_exp2f(-(acc[ai][0][m][n][j] + ba[j]) * LOG2E), eb = __builtin_amdgcn_exp2f(-(acc[ai][1][m][n][j] + bb[j]) * LOG2E);
                            gg[4 * n + j] = __builtin_amdgcn_rcpf(1.0f + eb); rr[4 * n + j] = (1.0f + eb) * __builtin_amdgcn_rcpf(1.0f + ea); } }
                    *(u32x4*)(gr_ + off) = pack8(rr); *(u32x4*)(gr_ + (size_t)MT * 2048 + off) = pack8(gg);
                    asm volatile("" ::: "memory"); }
        } else if (pn < 23) {
            const bool gate = false;
            bf16_t* const p0 = G; bf16_t* const p1 = DV; bf16_t* const p2 = RAWQ; bf16_t* const p3 = RAWKV;
            bf16_t* base = pn < 16 ? p0 : (pn < 20 ? p1 : (pn < 22 ? p2 : p3));
            const int colt = pn < 16 ? pn * BM : (pn < 20 ? (pn - 16) * BM : (pn < 22 ? (pn - 20) * BM : 0));
            const int psh = pn < 16 ? 12 : (pn < 20 ? 10 : (pn < 22 ? 9 : 8));
            const int col0 = colt + wc * 32 + 8 * fq;
            f32x4 bv[2][2];
#pragma unroll
            for (int bj = 0; bj < 2; ++bj)
#pragma unroll
                for (int n = 0; n < 2; ++n) bv[bj][n] = gate ? *(const f32x4*)(bgate + col0 + bj * HALF + 4 * n) : (f32x4){0.f, 0.f, 0.f, 0.f};
#pragma unroll
            for (int ai = 0; ai < 2; ++ai)
#pragma unroll
                for (int m = 0; m < 4; ++m) { const int row = row0 + ai * HALF + m * 16; bf16_t* rowp = base + ((size_t)row << psh) + col0; float ss = 0.f;
#pragma unroll
                    for (int bj = 0; bj < 2; ++bj) { f32x4 v0 = acc[ai][bj][m][0] + bv[bj][0], v1 = acc[ai][bj][m][1] + bv[bj][1];
                        if (gate) {
#pragma unroll
                            for (int j = 0; j < 4; ++j) { v0[j] = sigmoidf_fast(v0[j]); v1[j] = sigmoidf_fast(v1[j]); } }
                        ss += (v0[0] * v0[0] + v0[1] * v0[1]) + (v0[2] * v0[2] + v0[3] * v0[3]) + (v1[0] * v1[0] + v1[1] * v1[1]) + (v1[2] * v1[2] + v1[3] * v1[3]);
                        u32x4 w; w.x = pk_bf16(v0[0], v0[1]); w.y = pk_bf16(v0[2], v0[3]); w.z = pk_bf16(v1[0], v1[1]); w.w = pk_bf16(v1[2], v1[3]);
                        *(u32x4*)(rowp + bj * HALF) = w; }
                    if (pn >= 20) { ss += __shfl_xor(ss, 16); ss += __shfl_xor(ss, 32); if (fq == 0) SSQ[(size_t)row * 12 + (pn - 20) * 4 + wc] = ss; } }
        } else {
            const bool isq = pn < 27, iskpe = pn == 31;
            if (iskpe && wc != 0) return;
            const float* const ga = gqd; const float* const gb = gkd; const float* const gc = gkm + 128;
            const float* gp = isq ? ga : (iskpe ? gc : gb);
            bf16_t* const o0 = DQ; bf16_t* const o1 = DK; bf16_t* const o2 = KPE;
            bf16_t* ob = isq ? o0 : (iskpe ? o2 : o1);
            const int osh = iskpe ? 6 : 10, grp = iskpe ? 0 : 4 * (pn - (isq ? 23 : 27)) + wc;
            const float qs = isq ? QS_DIFF : 1.0f;
            f32x4 g0[2], g1[2]; float invf[2][4];
#pragma unroll
            for (int n = 0; n < 2; ++n) { g0[n] = *(const f32x4*)(gp + 8 * fq + 4 * n); g1[n] = *(const f32x4*)(gp + 32 + 8 * fq + 4 * n);
#pragma unroll
                for (int j = 0; j < 4; ++j) invf[n][j] = rope_invf(8 * fq + 4 * n + j); }
#pragma unroll
            for (int ai = 0; ai < 2; ++ai)
#pragma unroll
                for (int m = 0; m < 4; ++m) { const int row = row0 + ai * HALF + m * 16; const float posf = (float)pos[row];
                    float ss = 0.f;
#pragma unroll
                    for (int bj = 0; bj < 2; ++bj)
#pragma unroll
                        for (int n = 0; n < 2; ++n) { const f32x4 x = acc[ai][bj][m][n]; ss += (x[0] * x[0] + x[1] * x[1]) + (x[2] * x[2] + x[3] * x[3]); }
                    ss += __shfl_xor(ss, 16); ss += __shfl_xor(ss, 32);
                    const float rs = qs / sqrtf(ss * (1.0f / 64.0f) + EPS);
                    float lo[8], hi8[8];
#pragma unroll
                    for (int n = 0; n < 2; ++n)
#pragma unroll
                        for (int j = 0; j < 4; ++j) { float cs, sn; rope_cs2(posf, invf[n][j], cs, sn);
                            const float a = acc[ai][0][m][n][j] * g0[n][j], b = acc[ai][1][m][n][j] * g1[n][j];
                            lo[4 * n + j] = rs * (a * cs - b * sn); hi8[4 * n + j] = rs * (b * cs + a * sn); }
                    bf16_t* op = ob + ((size_t)row << osh) + 64 * grp + 8 * fq;
                    *(u32x4*)op = pack8(lo); *(u32x4*)(op + 32) = pack8(hi8); }
        }
    }
};
struct EpiQ {
    bf16_t* QM; const float* SSQ; const float* gq; const int* pos; LAS float* xch;
    __device__ __forceinline__ void operator()(const f32x4 (&acc)[2][2][4][2], const Unit& u, int wr, int wc, int fr, int fq) const {
        const int row0 = u.pm * BM + wr * 64 + fr; const int hb = u.pn / 3, tt = u.pn % 3;
#define EPI_SS16(dst) do { float ss_ = 0.f; _Pragma("unroll") for (int bj = 0; bj < 2; ++bj) _Pragma("unroll") for (int n = 0; n < 2; ++n) { const f32x4 x = acc[ai][bj][m][n]; ss_ += (x[0] * x[0] + x[1] * x[1]) + (x[2] * x[2] + x[3] * x[3]); } \
        ss_ += __shfl_xor(ss_, 16); ss_ += __shfl_xor(ss_, 32); dst = ss_; } while (0)
#define EPI_RQ(dst, row) do { const float* sp_ = SSQ + (size_t)(row) * 12; const f32x4 a_ = *(const f32x4*)sp_, b_ = *(const f32x4*)(sp_ + 4); \
        dst = 1.0f / sqrtf(((a_[0] + a_[1]) + (a_[2] + a_[3]) + (b_[0] + b_[1]) + (b_[2] + b_[3])) * (1.0f / 512.0f) + EPS); } while (0)
        if (tt < 2) {
            const int h = 4 * hb + 2 * tt + (wc >> 1), gg = wc & 1;
#pragma unroll
            for (int ai = 0; ai < 2; ++ai)
#pragma unroll
                for (int m = 0; m < 4; ++m) { float s1; EPI_SS16(s1); if (fq == 0) xch[(ai * HALF + wr * 64 + m * 16 + fr) * 4 + wc] = s1; }
            EPI_LDS_BAR();
            f32x4 g0[2], g1[2];
#pragma unroll
            for (int n = 0; n < 2; ++n) { g0[n] = *(const f32x4*)(gq + 64 * gg + 8 * fq + 4 * n); g1[n] = *(const f32x4*)(gq + 64 * gg + 32 + 8 * fq + 4 * n); }
#pragma unroll
            for (int ai = 0; ai < 2; ++ai)
#pragma unroll
                for (int m = 0; m < 4; ++m) { const int row = row0 + ai * HALF + m * 16; float r; EPI_RQ(r, row);
                    const LAS float* xr = xch + (ai * HALF + wr * 64 + m * 16 + fr) * 4 + (wc & 2);
                    const float tot = xr[0] + xr[1];
                    const float f = QS_MLA * r / sqrtf(r * r * tot * (1.0f / 128.0f) + EPS);
                    float lo[8], hi8[8];
#pragma unroll
                    for (int n = 0; n < 2; ++n)
#pragma unroll
                        for (int j = 0; j < 4; ++j) { lo[4 * n + j] = f * acc[ai][0][m][n][j] * g0[n][j]; hi8[4 * n + j] = f * acc[ai][1][m][n][j] * g1[n][j]; }
                    bf16_t* op = QM + (size_t)row * 1536 + 192 * h + 64 * gg + 8 * fq;
                    *(u32x4*)op = pack8(lo); *(u32x4*)(op + 32) = pack8(hi8); }
        } else {
            const int h = 4 * hb + wc;
            f32x4 g0[2], g1[2]; float invf[2][4];
#pragma unroll
            for (int n = 0; n < 2; ++n) { g0[n] = *(const f32x4*)(gq + 128 + 8 * fq + 4 * n); g1[n] = *(const f32x4*)(gq + 160 + 8 * fq + 4 * n);
#pragma unroll
                for (int j = 0; j < 4; ++j) invf[n][j] = rope_invf(8 * fq + 4 * n + j); }
#pragma unroll
            for (int ai = 0; ai < 2; ++ai)
#pragma unroll
                for (int m = 0; m < 4; ++m) { const int row = row0 + ai * HALF + m * 16; float r; EPI_RQ(r, row); const float posf = (float)pos[row];
                    float ss1; EPI_SS16(ss1);
                    const float f = QS_MLA * r / sqrtf(r * r * ss1 * (1.0f / 64.0f) + EPS);
                    float lo[8], hi8[8];
#pragma unroll
                    for (int n = 0; n < 2; ++n)
#pragma unroll
                        for (int j = 0; j < 4; ++j) { float cs, sn; rope_cs2(posf, invf[n][j], cs, sn);
                            const float a = acc[ai][0][m][n][j] * g0[n][j], b = acc[ai][1][m][n][j] * g1[n][j];
                            lo[4 * n + j] = f * (a * cs - b * sn); hi8[4 * n + j] = f * (b * cs + a * sn); }
                    bf16_t* op = QM + (size_t)row * 1536 + 192 * h + 128 + 8 * fq;
                    *(u32x4*)op = pack8(lo); *(u32x4*)(op + 32) = pack8(hi8); }
        }
    }
};
struct EpiKV {
    bf16_t* KN; bf16_t* VM; const float* SSQ; const float* gk; LAS float* xch;
    __device__ __forceinline__ void operator()(const f32x4 (&acc)[2][2][4][2], const Unit& u, int wr, int wc, int fr, int fq) const {
        const int row0 = u.pm * BM + wr * 64 + fr; const int h = u.pn;
#pragma unroll
        for (int ai = 0; ai < 2; ++ai)
#pragma unroll
            for (int m = 0; m < 4; ++m) { float s1; EPI_SS16(s1); if (fq == 0) xch[(ai * HALF + wr * 64 + m * 16 + fr) * 4 + wc] = s1; }
        EPI_LDS_BAR();
        const int gg = wc & 1;
        if (wc < 2) {
            f32x4 g0[2], g1[2];
#pragma unroll
            for (int n = 0; n < 2; ++n) { g0[n] = *(const f32x4*)(gk + 64 * gg + 8 * fq + 4 * n); g1[n] = *(const f32x4*)(gk + 64 * gg + 32 + 8 * fq + 4 * n); }
#pragma unroll
            for (int ai = 0; ai < 2; ++ai)
#pragma unroll
                for (int m = 0; m < 4; ++m) { const int row = row0 + ai * HALF + m * 16;
                    float r; { const f32x4 a_ = *(const f32x4*)(SSQ + (size_t)row * 12 + 8); r = 1.0f / sqrtf(((a_[0] + a_[1]) + (a_[2] + a_[3])) * (1.0f / 256.0f) + EPS); }
                    const LAS float* xr = xch + (ai * HALF + wr * 64 + m * 16 + fr) * 4 + (wc & 2);
                    const float tot = xr[0] + xr[1];
                    const float f = r / sqrtf(r * r * tot * (1.0f / 128.0f) + EPS);
                    float lo[8], hi8[8];
#pragma unroll
                    for (int n = 0; n < 2; ++n)
#pragma unroll
                        for (int j = 0; j < 4; ++j) { lo[4 * n + j] = f * acc[ai][0][m][n][j] * g0[n][j]; hi8[4 * n + j] = f * acc[ai][1][m][n][j] * g1[n][j]; }
                    bf16_t* op = KN + (size_t)row * 1024 + 128 * h + 64 * gg + 8 * fq;
                    *(u32x4*)op = pack8(lo); *(u32x4*)(op + 32) = pack8(hi8);
                    asm volatile("" ::: "memory"); }
        } else {
#pragma unroll
            for (int ai = 0; ai < 2; ++ai)
#pragma unroll
                for (int m = 0; m < 4; ++m) { const int row = row0 + ai * HALF + m * 16;
                    float r; { const f32x4 a_ = *(const f32x4*)(SSQ + (size_t)row * 12 + 8); r = 1.0f / sqrtf(((a_[0] + a_[1]) + (a_[2] + a_[3])) * (1.0f / 256.0f) + EPS); }
                    float lo[8], hi8[8];
#pragma unroll
                    for (int n = 0; n < 2; ++n)
#pragma unroll
                        for (int j = 0; j < 4; ++j) { lo[4 * n + j] = r * acc[ai][0][m][n][j]; hi8[4 * n + j] = r * acc[ai][1][m][n][j]; }
                    bf16_t* op = VM + (size_t)row * 1024 + 128 * h + 64 * gg + 8 * fq;
                    *(u32x4*)op = pack8(lo); *(u32x4*)(op + 32) = pack8(hi8);
                    asm volatile("" ::: "memory"); }
        }
    }
};
#undef EPI_SS16
#undef EPI_RQ
struct EpiPlain {
    bf16_t* O; int ldc;
    __device__ __forceinline__ void operator()(const f32x4 (&acc)[2][2][4][2], const Unit& u, int wr, int wc, int fr, int fq) const {
        const int row0 = u.pm * BM + wr * 64 + fr; const int col0 = u.pn * BM + wc * 32 + 8 * fq;
#pragma unroll
        for (int ai = 0; ai < 2; ++ai)
#pragma unroll
            for (int m = 0; m < 4; ++m) { bf16_t* rowp = O + (size_t)(row0 + ai * HALF + m * 16) * ldc + col0;
#pragma unroll
                for (int bj = 0; bj < 2; ++bj) { const f32x4 v0 = acc[ai][bj][m][0], v1 = acc[ai][bj][m][1];
                    u32x4 w; w.x = pk_bf16(v0[0], v0[1]); w.y = pk_bf16(v0[2], v0[3]); w.z = pk_bf16(v1[0], v1[1]); w.w = pk_bf16(v1[2], v1[3]);
                    *(u32x4*)(rowp + bj * HALF) = w; } }
    }
};
template <bool ADD> struct EpiGate {
    bf16_t* O; const bf16_t* Tin; const bf16_t* Gt; int gcol;
    __device__ __forceinline__ void operator()(const f32x4 (&acc)[2][2][4][2], const Unit& u, int wr, int wc, int fr, int fq) const {
        const int row0 = u.pm * BM + wr * 64 + fr; const int col0 = u.pn * BM + wc * 32 + 8 * fq;
#pragma unroll
        for (int ai = 0; ai < 2; ++ai)
#pragma unroll
            for (int m = 0; m < 4; ++m) { const size_t row = (size_t)(row0 + ai * HALF + m * 16);
#pragma unroll
                for (int bj = 0; bj < 2; ++bj) { const f32x4 v0 = acc[ai][bj][m][0], v1 = acc[ai][bj][m][1];
                    const int col = col0 + bj * HALF;
                    const u32x4 gr = *(const u32x4*)(Gt + row * DM + gcol + col); float g[8]; unpack8(gr, g);
                    float o[8];
#pragma unroll
                    for (int j = 0; j < 4; ++j) { o[j] = g[j] * v0[j]; o[4 + j] = g[4 + j] * v1[j]; }
                    if (ADD) { const u32x4 tr = *(const u32x4*)(Tin + row * DM + col); float t[8]; unpack8(tr, t);
#pragma unroll
                        for (int j = 0; j < 8; ++j) o[j] += t[j]; }
                    *(u32x4*)(O + row * DM + col) = pack8(o); } }
    }
};
struct RatioHook {
    const bf16_t* Gt;
    __device__ __forceinline__ void operator()(f32x4 (&acc)[2][2][4][2], const Unit& u, int wr, int wc, int fr, int fq) const {
        const int row0 = u.pm * BM + wr * 64 + fr; const int col0 = u.pn * BM + wc * 32 + 8 * fq;
#pragma unroll
        for (int ai = 0; ai < 2; ++ai)
#pragma unroll
            for (int m = 0; m < 4; ++m) { const bf16_t* gp = Gt + (size_t)(row0 + ai * HALF + m * 16) * 2048 + col0;
#pragma unroll
                for (int bj = 0; bj < 2; ++bj) {
                    const u32x4 ar = *(const u32x4*)(gp + bj * HALF);
                    float a[8]; unpack8(ar, a);
#pragma unroll
                    for (int j = 0; j < 4; ++j) { acc[ai][bj][m][0][j] *= a[j]; acc[ai][bj][m][1][j] *= a[4 + j]; }
                    asm volatile("" : "+v"(acc[ai][bj][m][0]), "+v"(acc[ai][bj][m][1]) :: "memory"); __builtin_amdgcn_sched_barrier(0);
                } }
    }
};
struct EpiRes1 {
    const float* base; bf16_t* out; const float* gatev;
    __device__ __forceinline__ void operator()(const f32x4 (&acc)[2][2][4][2], const Unit& u, int wr, int wc, int fr, int fq) const {
        const int row0 = u.pm * BM + wr * 64 + fr; const int col0 = u.pn * BM + wc * 32 + 8 * fq;
        const float* gp = gatev + (size_t)(u.pm >> 4) * (6 * DM);
        f32x4 gv[2][2];
#pragma unroll
        for (int bj = 0; bj < 2; ++bj)
#pragma unroll
            for (int n = 0; n < 2; ++n) gv[bj][n] = *(const f32x4*)(gp + col0 + bj * HALF + 4 * n);
#pragma unroll
        for (int ai = 0; ai < 2; ++ai)
#pragma unroll
            for (int m = 0; m < 4; ++m) { const size_t off = (size_t)(row0 + ai * HALF + m * 16) * DM + col0;
#pragma unroll
                for (int bj = 0; bj < 2; ++bj) { const f32x4 b0 = *(const f32x4*)(base + off + bj * HALF), b1 = *(const f32x4*)(base + off + bj * HALF + 4);
                    const f32x4 v0 = b0 + gv[bj][0] * acc[ai][bj][m][0], v1 = b1 + gv[bj][1] * acc[ai][bj][m][1];
                    u32x4 w; w.x = pk_bf16(v0[0], v0[1]); w.y = pk_bf16(v0[2], v0[3]); w.z = pk_bf16(v1[0], v1[1]); w.w = pk_bf16(v1[2], v1[3]);
                    *(u32x4*)(out + off + bj * HALF) = w; } }
    }
};
struct EpiRes2 {
    const bf16_t* base; float* out; const float* gatev;
    __device__ __forceinline__ void operator()(const f32x4 (&acc)[2][2][4][2], const Unit& u, int wr, int wc, int fr, int fq) const {
        const int row0 = u.pm * BM + wr * 64 + fr; const int col0 = u.pn * BM + wc * 32 + 8 * fq;
        const float* gp = gatev + (size_t)(u.pm >> 4) * (6 * DM);
        f32x4 gv[2][2];
#pragma unroll
        for (int bj = 0; bj < 2; ++bj)
#pragma unroll
            for (int n = 0; n < 2; ++n) gv[bj][n] = *(const f32x4*)(gp + col0 + bj * HALF + 4 * n);
#pragma unroll
        for (int ai = 0; ai < 2; ++ai)
#pragma unroll
            for (int m = 0; m < 4; ++m) { const size_t off = (size_t)(row0 + ai * HALF + m * 16) * DM + col0;
#pragma unroll
                for (int bj = 0; bj < 2; ++bj) { const u32x4 br = *(const u32x4*)(base + off + bj * HALF); float bs[8]; unpack8(br, bs);
                    *(f32x4*)(out + off + bj * HALF) = (f32x4){bs[0], bs[1], bs[2], bs[3]} + gv[bj][0] * acc[ai][bj][m][0];
                    *(f32x4*)(out + off + bj * HALF + 4) = (f32x4){bs[4], bs[5], bs[6], bs[7]} + gv[bj][1] * acc[ai][bj][m][1]; } }
    }
};
__device__ __forceinline__ float dpp_shift1(float cur, float prev) {
    const int t = __builtin_amdgcn_update_dpp(0, __float_as_int(prev), 0x121, 0xf, 0xf, false);
    return __int_as_float(__builtin_amdgcn_update_dpp(t, __float_as_int(cur), 0x111, 0xf, 0xf, false));
}
__device__ __forceinline__ float dpp_shift2(float cur, float prev) {
    const int t = __builtin_amdgcn_update_dpp(0, __float_as_int(prev), 0x122, 0xf, 0xf, false);
    return __int_as_float(__builtin_amdgcn_update_dpp(t, __float_as_int(cur), 0x112, 0xf, 0xf, false));
}
struct EpiConv {
    bf16_t* ACT; float* SIDE; const float* cw; const float* cb;
    __device__ __forceinline__ void operator()(const f32x4 (&acc)[2][2][4][2], const Unit& u, int wr, int wc, int fr, int fq) const {
#pragma unroll
        for (int n = 0; n < 2; ++n) {
            const int ch = u.pn * 128 + wc * 32 + 8 * fq + 4 * n;
            const f32x4 w0v = *(const f32x4*)(cw + ch), w1v = *(const f32x4*)(cw + NUP + ch), w2v = *(const f32x4*)(cw + 2 * NUP + ch), bv = *(const f32x4*)(cb + ch);
            const f32x4 w0g = *(const f32x4*)(cw + DFF + ch), w1g = *(const f32x4*)(cw + NUP + DFF + ch), w2g = *(const f32x4*)(cw + 2 * NUP + DFF + ch), bg = *(const f32x4*)(cb + DFF + ch);
#pragma unroll
            for (int ai = 0; ai < 2; ++ai) {
                const int seg = u.pm * 4 + ai * 2 + wr;
#pragma unroll
                for (int m = 0; m < 4; ++m) {
                    const f32x4 uv = acc[ai][0][m][n], ug = acc[ai][1][m][n];
                    const f32x4 pv = m ? acc[ai][0][m ? m - 1 : 0][n] : (f32x4){0.f, 0.f, 0.f, 0.f};
                    const f32x4 pg = m ? acc[ai][1][m ? m - 1 : 0][n] : (f32x4){0.f, 0.f, 0.f, 0.f};
                    f32x4 a;
#pragma unroll
                    for (int j = 0; j < 4; ++j) {
                        const float s1v = dpp_shift1(uv[j], pv[j]), s2v = dpp_shift2(uv[j], pv[j]);
                        const float s1g = dpp_shift1(ug[j], pg[j]), s2g = dpp_shift2(ug[j], pg[j]);
                        const float yv = bv[j] + w2v[j] * uv[j] + w1v[j] * s1v + w0v[j] * s2v;
                        const float yg = bg[j] + w2g[j] * ug[j] + w1g[j] * s1g + w0g[j] * s2g;
                        a[j] = yv * yg * sigmoidf_fast(yg);
                    }
                    const size_t row = (size_t)seg * 64 + m * 16 + fr;
                    if (m > 0 || fr >= 2) { u32x2 w; w.x = pk_bf16(a[0], a[1]); w.y = pk_bf16(a[2], a[3]); *(u32x2*)(ACT + row * DFF + ch) = w; }
                    if (m == 0 && fr < 2) { float* sp = SIDE + ((size_t)seg * 4 + fr) * NUP + ch; *(f32x4*)sp = uv; *(f32x4*)(sp + DFF) = ug; }
                    if (m == 3 && fr >= 14) { float* sp = SIDE + ((size_t)seg * 4 + 2 + (fr - 14)) * NUP + ch; *(f32x4*)sp = uv; *(f32x4*)(sp + DFF) = ug; }
                }
            }
        }
    }
};

struct NoHook { __device__ __forceinline__ void operator()(f32x4 (&)[2][2][4][2], const Unit&, int, int, int, int) const {} };
template <class Epi, bool HOOK = false, class Hook = NoHook>
__device__ __forceinline__ void gemm_phase(LAS unsigned char* lds, const Gemm g, const StaticOrder& S, const Epi& E, const Hook& Hk = Hook()) {
    const int tid = threadIdx.x, wid = __builtin_amdgcn_readfirstlane(tid >> 6), lane = tid & 63, wr = wid >> 2, wc = wid & 3, fr = lane & 15, fq = lane >> 4;
    const int K = g.K, nt = K / BK, lda = g.lda, ldb = g.ldb ? g.ldb : g.K;
    const size_t halfoff = (size_t)K * 2;
    unsigned voffA[2], voffB[2];
#pragma unroll
    for (int i = 0; i < 2; ++i) { int R, C; stage_rc(tid * 16 + i * 8192, R, C); const int Rb = (R & ~31) + perm32(R & 31);
        voffA[i] = (unsigned)(R * lda + C) * 2u; voffB[i] = (unsigned)(Rb * ldb + C) * 2u; }
    const size_t kstep = (size_t)(BK * 2);
    const size_t hstepA = (size_t)HALF * lda * 2, hstepB = (size_t)HALF * ldb * 2;
    const size_t tstepA = 2 * hstepA, tstepB = 2 * hstepB;
    const unsigned ldsw = (unsigned)wid * 1024u;
    const int aoff = lds_byte(wr * 64 + fr, fq * 8), boff = lds_byte(wc * 32 + fr, fq * 8);
#define PG8_SA(b, h) (((b) * 2 + (h)) * HTB)
#define PG8_SB(b, h) ((4 + (b) * 2 + (h)) * HTB)
#define PG8_STAGE(bufoff, gbase, voff) do { _Pragma("unroll") for (int _i = 0; _i < 2; ++_i) \
        __builtin_amdgcn_global_load_lds((const unsigned*)((const char*)(gbase) + (voff)[_i]), (LAS unsigned*)(lds + (bufoff) + ldsw + _i * 8192), 16, 0, 0); } while (0)
#define PG8_LDA(dst, b, h) do { _Pragma("unroll") for (int m = 0; m < 4; ++m) _Pragma("unroll") for (int k = 0; k < 2; ++k) dst[m][k] = *(const LAS bf16x8*)(lds + PG8_SA(b, h) + aoff + m * 2048 + k * 1024); } while (0)
#define PG8_LDB(dst, b, h) do { _Pragma("unroll") for (int n = 0; n < 2; ++n) _Pragma("unroll") for (int k = 0; k < 2; ++k) dst[n][k] = *(const LAS bf16x8*)(lds + PG8_SB(b, h) + boff + n * 2048 + k * 1024); } while (0)
#define PG8_MMA(ai, bj, At, Bt) do { __builtin_amdgcn_s_setprio(1); _Pragma("unroll") for (int m = 0; m < 4; ++m) _Pragma("unroll") for (int n = 0; n < 2; ++n) _Pragma("unroll") for (int k = 0; k < 2; ++k) \
        acc[ai][bj][m][n] = __builtin_amdgcn_mfma_f32_16x16x32_bf16(Bt[n][k], At[m][k], acc[ai][bj][m][n], 0, 0, 0); __builtin_amdgcn_s_setprio(0); } while (0)
#define PG8_WAIT_V(n) asm volatile("s_waitcnt vmcnt(" #n ")" ::: "memory")
#define PG8_WAIT_L(n) asm volatile("s_waitcnt lgkmcnt(" #n ")" ::: "memory")
#define PG8_BAR __builtin_amdgcn_s_barrier()
#define PG8_SCHED __builtin_amdgcn_sched_barrier(0)
    Unit cur, nxt; int ui = 0;
    if (!S.next(0, cur)) return;
    f32x4 acc[2][2][4][2];
#pragma unroll
    for (int a = 0; a < 2; ++a)
#pragma unroll
        for (int b = 0; b < 2; ++b)
#pragma unroll
            for (int m = 0; m < 4; ++m)
#pragma unroll
                for (int n = 0; n < 2; ++n) acc[a][b][m][n] = (f32x4){0.f, 0.f, 0.f, 0.f};
    bf16x8 At[4][2], B0[2][2], B1[2][2];
    const char* cA = (const char*)g.A + (size_t)cur.pm * tstepA; const char* cB = (const char*)g.Bt + (size_t)cur.pn * tstepB;
    PG8_STAGE(PG8_SB(0, 0), cB, voffB); PG8_STAGE(PG8_SB(0, 1), cB + hstepB, voffB); PG8_STAGE(PG8_SA(0, 0), cA, voffA); PG8_STAGE(PG8_SA(0, 1), cA + hstepA, voffA);
    if (wr == 1) PG8_BAR;
    PG8_WAIT_V(2); PG8_BAR;
    PG8_STAGE(PG8_SB(1, 0), cB + kstep, voffB); PG8_STAGE(PG8_SA(1, 0), cA + kstep, voffA); PG8_STAGE(PG8_SB(1, 1), cB + hstepB + kstep, voffB);
    PG8_WAIT_V(6); PG8_BAR;
    for (;;) {
        const bool has_next = HOOK ? (((ui + 1) & 1) ? (nxt = cur, true) : S.next((ui + 1) >> 1, nxt)) : S.next(ui + 1, nxt);
        const size_t nho = (HOOK && ((ui + 1) & 1)) ? halfoff : 0;
        const char* nA = has_next ? (const char*)g.A + (size_t)nxt.pm * tstepA + nho : cA; const char* nB = has_next ? (const char*)g.Bt + (size_t)nxt.pn * tstepB + nho : cB;
        for (int t = 0; t < nt; t += 2) {
            const bool last = (t == nt - 2);
            const char* a1 = cA + (size_t)(t + 1) * kstep;
            const char* a2 = last ? nA : cA + (size_t)(t + 2) * kstep; const char* b2 = last ? nB : cB + (size_t)(t + 2) * kstep;
            const char* a3 = a2 + kstep; const char* b3 = b2 + kstep;
            PG8_LDB(B0, 0, 0); PG8_LDB(B1, 0, 1); PG8_SCHED; PG8_LDA(At, 0, 0); PG8_STAGE(PG8_SA(1, 1), a1 + hstepA, voffA);
            PG8_WAIT_V(8); PG8_WAIT_L(0); PG8_BAR; PG8_MMA(0, 0, At, B0); PG8_MMA(0, 1, At, B1); PG8_BAR; PG8_SCHED;
            PG8_LDA(At, 0, 1); PG8_STAGE(PG8_SB(0, 0), b2, voffB); PG8_STAGE(PG8_SB(0, 1), b2 + hstepB, voffB); PG8_STAGE(PG8_SA(0, 0), a2, voffA);
            PG8_WAIT_V(8); PG8_WAIT_L(0); PG8_BAR; PG8_MMA(1, 0, At, B0); PG8_MMA(1, 1, At, B1); PG8_BAR; PG8_SCHED;
            PG8_LDB(B0, 1, 0); PG8_LDB(B1, 1, 1); PG8_SCHED; PG8_LDA(At, 1, 0); PG8_STAGE(PG8_SA(0, 1), a2 + hstepA, voffA);
            PG8_WAIT_V(8); PG8_WAIT_L(0); PG8_BAR; PG8_MMA(0, 0, At, B0); PG8_MMA(0, 1, At, B1); PG8_BAR; PG8_SCHED;
            PG8_LDA(At, 1, 1); PG8_STAGE(PG8_SB(1, 0), b3, voffB); PG8_STAGE(PG8_SB(1, 1), b3 + hstepB, voffB); PG8_STAGE(PG8_SA(1, 0), a3, voffA);
            PG8_WAIT_V(8); PG8_WAIT_L(0); PG8_BAR; PG8_MMA(1, 0, At, B0); PG8_MMA(1, 1, At, B1); PG8_BAR; PG8_SCHED;
        }
        if (wr == 0) PG8_BAR;
        const bool half0 = HOOK && !(ui & 1);
        if (half0) Hk(acc, cur, wr, wc, fr, fq); else E(acc, cur, wr, wc, fr, fq);
        if (!has_next) break;
        { const float keep = half0 ? 1.0f : 0.0f;
#pragma unroll
        for (int a = 0; a < 2; ++a)
#pragma unroll
            for (int b = 0; b < 2; ++b)
#pragma unroll
                for (int m = 0; m < 4; ++m)
#pragma unroll
                    for (int n = 0; n < 2; ++n) { if (HOOK) acc[a][b][m][n] = acc[a][b][m][n] * keep; else acc[a][b][m][n] = (f32x4){0.f, 0.f, 0.f, 0.f}; } }
        cur = nxt; cA = nA; cB = nB; ++ui;
        if (wr == 1) PG8_BAR;
    }
    PG8_WAIT_V(0);
    PG8_BAR;
#undef PG8_SA
#undef PG8_SB
#undef PG8_STAGE
#undef PG8_LDA
#undef PG8_LDB
#undef PG8_MMA
#undef PG8_WAIT_V
#undef PG8_WAIT_L
#undef PG8_BAR
#undef PG8_SCHED
}
}

namespace att {
#define MFMA32(a, b, c) __builtin_amdgcn_mfma_f32_32x32x16_bf16((a), (b), (c), 0, 0, 0)
__device__ __forceinline__ int crow(int r, int hi) { return (r & 3) + 8 * (r >> 2) + 4 * hi; }
typedef short v4i16 __attribute__((ext_vector_type(4)));
template <int DQK> struct Cfg { static constexpr int KCH = DQK / 8, KROWB = DQK * 2, NKC = (64 * KCH) / 512, KBYTES = 64 * KROWB, VBYTES = 64 * 256, VOFF = 3 * KBYTES, TOTAL = 3 * KBYTES + 4 * VBYTES, NDMA = NKC + 2; };

template <int DQK>
__device__ __forceinline__ void attn_tiles(const bf16_t* __restrict__ Qg, int qpitch, const bf16_t* __restrict__ Kg, int kpitch, const bf16_t* __restrict__ Kpe,
                                           const bf16_t* __restrict__ Vg, int vpitch, int q0, LAS unsigned char* lds, f32x16 (&o)[4], float& l_out) {
    typedef Cfg<DQK> C;
    int tid_ = threadIdx.x; asm volatile("" : "+v"(tid_));
    const int tid = tid_, lane = tid & 63, r32 = lane & 31, hi = lane >> 5; const int w = __builtin_amdgcn_readfirstlane(tid >> 6);
    const int NT = (q0 + 256) / 64;
    const int tl = NT - 4 + (w >> 1);
    bf16x8 qf[DQK / 16];
    { const bf16_t* qrow = Qg + (size_t)(q0 + 32 * w + r32) * qpitch + 8 * hi;
#pragma unroll
      for (int ds = 0; ds < DQK / 16; ++ds) qf[ds] = *(const bf16x8*)(qrow + 16 * ds); }
    unsigned koff[C::NKC]; bool kpe_[C::NKC];
#pragma unroll
    for (int i = 0; i < C::NKC; ++i) { const int P = tid + 512 * i, kr = P / C::KCH, cp = P % C::KCH, kc = (cp & ~7) | ((cp ^ (kr >> 1)) & 7); kpe_[i] = (DQK == 192) && kc >= 16;
        koff[i] = kpe_[i] ? (unsigned)(kr * 64 + 8 * (kc - 16)) : (unsigned)(kr * kpitch + 8 * kc); }
    const unsigned voff = (unsigned)((tid >> 4) * vpitch + 8 * ((((((tid & 15) >> 1) ^ (2 * ((tid >> 4) & 3))) << 1) | (tid & 1))));
#define ATT_DMA(t) do { const bf16_t* kt_ = Kg + (size_t)(64 * (t)) * kpitch; const bf16_t* kp_ = Kpe + (size_t)(64 * (t)) * 64; const bf16_t* vt_ = Vg + (size_t)(64 * (t)) * vpitch; \
        LAS unsigned char* kb_ = lds + ((t) % 3) * C::KBYTES + w * 1024; LAS unsigned char* vb_ = lds + C::VOFF + ((t) & 3) * C::VBYTES + w * 1024; \
        _Pragma("unroll") for (int i = 0; i < C::NKC; ++i) __builtin_amdgcn_global_load_lds((const unsigned*)((kpe_[i] ? kp_ : kt_) + koff[i]), (LAS unsigned*)(kb_ + i * 8192), 16, 0, 0); \
        __builtin_amdgcn_global_load_lds((const unsigned*)(vt_ + voff), (LAS unsigned*)(vb_), 16, 0, 0); \
        __builtin_amdgcn_global_load_lds((const unsigned*)(vt_ + voff + 32 * vpitch), (LAS unsigned*)(vb_ + 8192), 16, 0, 0); } while (0)
#define ATT_WAITBAR(n) do { asm volatile("s_waitcnt vmcnt(%0)" :: "n"(n) : "memory"); __builtin_amdgcn_s_barrier(); asm volatile("" ::: "memory"); } while (0)
#pragma unroll
    for (int d = 0; d < 4; ++d)
#pragma unroll
        for (int i = 0; i < 16; ++i) o[d][i] = 0.f;
    float m_used = -INFINITY, l = 0.f;
    const unsigned hs16 = (unsigned)(((hi ^ (r32 >> 1)) & 7) * 16);
    const unsigned kbase = (unsigned)(r32 * C::KROWB);
    const int q4 = (lane & 15) >> 2;
    const unsigned vbase = (unsigned)(C::VOFF + (4 * hi + q4) * 256 + 32 * ((lane >> 4) & 1) + 8 * (lane & 3));
    unsigned xq[4];
#pragma unroll
    for (int db = 0; db < 4; ++db) xq[db] = (unsigned)((64 * db) ^ (64 * q4));
    bf16x8 pbp[4];
#pragma unroll
    for (int k = 0; k < 4; ++k) pbp[k] = (bf16x8){0, 0, 0, 0, 0, 0, 0, 0};
#define ATT_VLOAD1(ks, db) do { \
        const v4i16 lo_ = __builtin_amdgcn_ds_read_tr16_b64_v4i16((LAS v4i16*)(vp_ + (16 * (ks)) * 256 + xq[db])); \
        const v4i16 hh_ = __builtin_amdgcn_ds_read_tr16_b64_v4i16((LAS v4i16*)(vp_ + (16 * (ks) + 8) * 256 + xq[db])); \
        vf[db] = (bf16x8){lo_[0], lo_[1], lo_[2], lo_[3], hh_[0], hh_[1], hh_[2], hh_[3]}; } while (0)
#define ATT_PV_PLAIN(tp) do { const LAS unsigned char* vp_ = lds + vbase + ((tp) & 3) * C::VBYTES; bf16x8 vf[4]; \
        _Pragma("unroll") for (int db = 0; db < 4; ++db) ATT_VLOAD1(0, db); \
        _Pragma("unroll") for (int ks = 0; ks < 4; ++ks) { \
            _Pragma("unroll") for (int db = 0; db < 4; ++db) { o[db] = MFMA32(vf[db], pbp[ks], o[db]); if (ks < 3) ATT_VLOAD1(ks + 1, db); __builtin_amdgcn_sched_barrier(0); } } } while (0)
typedef float f32x2p __attribute__((ext_vector_type(2)));
#define ATT_EXP2P(S, a) do { f32x2p v_ = (f32x2p){S[a], S[(a) + 1]} + nm2; v_.x = __builtin_amdgcn_exp2f(v_.x); v_.y = __builtin_amdgcn_exp2f(v_.y); S[a] = v_.x; S[(a) + 1] = v_.y; ps2 = ps2 + v_; } while (0)
#define ATT_EXP2(k) do { if ((k) < 8) ATT_EXP2P(s0, 2 * (k)); else ATT_EXP2P(s1, 2 * ((k) - 8)); } while (0)
#define ATT_PACK() do { _Pragma("unroll") for (int s = 0; s < 2; ++s) { u32x4 a, b; \
        a.x = pk_bf16(s0[8 * s + 0], s0[8 * s + 1]); a.y = pk_bf16(s0[8 * s + 2], s0[8 * s + 3]); a.z = pk_bf16(s0[8 * s + 4], s0[8 * s + 5]); a.w = pk_bf16(s0[8 * s + 6], s0[8 * s + 7]); \
        b.x = pk_bf16(s1[8 * s + 0], s1[8 * s + 1]); b.y = pk_bf16(s1[8 * s + 2], s1[8 * s + 3]); b.z = pk_bf16(s1[8 * s + 4], s1[8 * s + 5]); b.w = pk_bf16(s1[8 * s + 6], s1[8 * s + 7]); \
        pbp[s] = __builtin_bit_cast(bf16x8, a); pbp[2 + s] = __builtin_bit_cast(bf16x8, b); } } while (0)
    ATT_DMA(0); ATT_DMA(1);
    ATT_WAITBAR(C::NDMA);
    int kst = 0;
    for (int t = 0; t < NT; ++t) {
        const bool more = (t + 2 < NT);
        if (more) ATT_DMA(t + 2);
        if (t <= tl) {
        f32x16 s0, s1;
        {
            const LAS unsigned char* kp0 = lds + kst * C::KBYTES + kbase;
#pragma unroll
            for (int i = 0; i < 16; ++i) { s0[i] = 0.f; s1[i] = 0.f; }
            bf16x8 ka[2], kb[2];
            { const unsigned a0 = hs16; ka[0] = *(const LAS bf16x8*)(kp0 + a0); kb[0] = *(const LAS bf16x8*)(kp0 + 32 * C::KROWB + a0); }
#pragma unroll
            for (int ds = 0; ds < DQK / 16; ++ds) {
                if (ds + 1 < DQK / 16) { const unsigned a1 = (unsigned)(16 * ((2 * (ds + 1)) & ~7)) + ((unsigned)(16 * ((2 * (ds + 1)) & 7)) ^ hs16);
                    ka[(ds + 1) & 1] = *(const LAS bf16x8*)(kp0 + a1); kb[(ds + 1) & 1] = *(const LAS bf16x8*)(kp0 + 32 * C::KROWB + a1); }
                s0 = MFMA32(ka[ds & 1], qf[ds], s0); s1 = MFMA32(kb[ds & 1], qf[ds], s1);
                __builtin_amdgcn_sched_barrier(0);
            }
        }
        const int jb = t - (NT - 4);
        if (jb >= 0) {
            const int qrel = 32 * w + r32 - 64 * jb - 4 * hi;
#pragma unroll
            for (int i = 0; i < 16; ++i) { if ((i & 3) + 8 * (i >> 2) > qrel) s0[i] = -INFINITY; if ((i & 3) + 8 * (i >> 2) + 32 > qrel) s1[i] = -INFINITY; }
        }
        if (t == 0) {
            float rm = fmaxf(s0[0], s1[0]);
#pragma unroll
            for (int i = 1; i < 16; ++i) rm = fmaxf(rm, fmaxf(s0[i], s1[i]));
            m_used = fmaxf(rm, __shfl_xor(rm, 32));
        }
        float ps_tile;
        {
            const LAS unsigned char* vp_ = lds + vbase + ((t ? t - 1 : 0) & 3) * C::VBYTES; bf16x8 vf[4];
            f32x2p ps2 = (f32x2p){0.f, 0.f}; const f32x2p nm2 = (f32x2p){-m_used, -m_used};
#pragma unroll
            for (int db = 0; db < 4; ++db) ATT_VLOAD1(0, db);
#pragma unroll
            for (int ks = 0; ks < 4; ++ks) {
#pragma unroll
                for (int db = 0; db < 4; ++db) { o[db] = MFMA32(vf[db], pbp[ks], o[db]); if (ks < 3) ATT_VLOAD1(ks + 1, db); ATT_EXP2(4 * ks + db); __builtin_amdgcn_sched_barrier(0); } }
            const float ps = ps2.x + ps2.y; l += ps; ps_tile = ps;
            ATT_PACK();
        }
        const float pst = ps_tile + __shfl_xor(ps_tile, 32);
        if (__any(pst > 4096.0f)) {
            const float gr = fmaxf(0.0f, __builtin_log2f(pst)); const float alpha = __builtin_amdgcn_exp2f(-gr); const float mn = m_used + gr;
            l *= alpha; m_used = mn;
#pragma unroll
            for (int d = 0; d < 4; ++d)
#pragma unroll
                for (int i = 0; i < 16; ++i) o[d][i] *= alpha;
#pragma unroll
            for (int k = 0; k < 4; ++k) { u32x4 pw = __builtin_bit_cast(u32x4, pbp[k]);
                pw.x = pk_bf16(bf_lo(pw.x) * alpha, bf_hi(pw.x) * alpha); pw.y = pk_bf16(bf_lo(pw.y) * alpha, bf_hi(pw.y) * alpha);
                pw.z = pk_bf16(bf_lo(pw.z) * alpha, bf_hi(pw.z) * alpha); pw.w = pk_bf16(bf_lo(pw.w) * alpha, bf_hi(pw.w) * alpha);
                pbp[k] = __builtin_bit_cast(bf16x8, pw); }
        }
        if (t == tl) ATT_PV_PLAIN(t);
        }
        if (more) ATT_WAITBAR(C::NDMA); else ATT_WAITBAR(0);
        kst = (kst == 2) ? 0 : kst + 1;
    }
    asm volatile("" ::: "memory"); __builtin_amdgcn_s_barrier(); asm volatile("" ::: "memory");
    l_out = l + __shfl_xor(l, 32);
#undef ATT_DMA
#undef ATT_WAITBAR
#undef ATT_VLOAD1
#undef ATT_PV_PLAIN
#undef ATT_EXP2
#undef ATT_EXP2P
#undef ATT_PACK
}
}

constexpr int NWAVES = 8, NTHREADS = 512;
constexpr int LDS_BYTES = 163840, MISC_OFF = 163584;
struct Args { const void* in[29]; float* out; unsigned char* ws; int ph_lo, ph_hi; };

struct Frame {
    LAS unsigned char* lds; int tid, lane, wave, G, gw, NGW;

};

__device__ __forceinline__ void transpose_item(const float* W, int Kp, int N, bf16_t* WT, int k0, int n0, int dst_row0, int hi_extra, const float* kgain, LAS float* scr, int lane) {
    const float* wp = W + (size_t)(k0 + (lane >> 4)) * N + n0 + 4 * (lane & 15);
    f32x4 v[16];
#pragma unroll
    for (int i = 0; i < 16; ++i) v[i] = *(const f32x4*)(wp + (size_t)(4 * i) * N);
    if (kgain) {
#pragma unroll
        for (int i = 0; i < 16; ++i) v[i] = v[i] * kgain[k0 + 4 * i + (lane >> 4)]; }
#pragma unroll
    for (int i = 0; i < 16; ++i) { LAS float* d = scr + (4 * i + (lane >> 4)) * 65 + 4 * (lane & 15); d[0] = v[i].x; d[1] = v[i].y; d[2] = v[i].z; d[3] = v[i].w; }
    asm volatile("s_waitcnt lgkmcnt(0)" ::: "memory");
    const int c = lane >> 3;
#pragma unroll
    for (int j = 0; j < 8; ++j) { const int n = (lane & 7) + 8 * j; const LAS float* s = scr + (8 * c) * 65 + n;
        u32x4 o; o.x = pk_bf16(s[0 * 65], s[1 * 65]); o.y = pk_bf16(s[2 * 65], s[3 * 65]); o.z = pk_bf16(s[4 * 65], s[5 * 65]); o.w = pk_bf16(s[6 * 65], s[7 * 65]);
        *(u32x4*)(WT + (size_t)(dst_row0 + n + (n >= 32 ? hi_extra : 0)) * Kp + k0 + 8 * c) = o; }
    asm volatile("s_waitcnt lgkmcnt(0)" ::: "memory");
}
__device__ __forceinline__ void transpose_weight(const Frame& F, const float* W, int K, int N, bf16_t* WT, int mode, int Kp = 0, const float* kgain = nullptr) {
    if (Kp == 0) Kp = K;
    LAS float* scr = (LAS float*)(F.lds + F.wave * 16640);
    const int nblk = N / 64, nitems = (K / 64) * nblk;
    for (int it = F.gw; it < nitems; it += F.NGW) {
        const int kb = it / nblk, nb = it % nblk, n0 = 64 * nb; int dst = n0;
        int hx = 0;
        if (mode == 1) {
            if (n0 >= R_END) { const int gc = n0 - R_END, isb = gc >= 2048, c = gc - isb * 2048; dst = 256 * (c >> 7) + 128 * isb + (c & 127); }
            else if (n0 >= R_DV) dst = 4096 + (n0 - R_DV);
            else if (n0 < R_KPE) dst = 5120 + n0;
            else if (n0 < R_DQ) { dst = 256 * 31; hx = 96; }
            else { const int g = (n0 - R_DQ) >> 6; dst = 256 * (23 + (g >> 2)) + 32 * (g & 3); hx = 96; }
        }
        if (mode == 2) { const int isg = n0 >= DFF, c = n0 - isg * DFF; dst = 256 * (c >> 7) + 128 * isg + (c & 127); }
        if (mode == 3) { const int h = n0 / 192, blk = (n0 % 192) >> 6, hb = h >> 2, hq = h & 3;
            dst = blk < 2 ? 256 * (3 * hb + (hq >> 1)) + 32 * (2 * (hq & 1) + blk) : 256 * (3 * hb + 2) + 32 * hq; hx = 96; }
        if (mode == 4) { dst = 256 * (n0 >> 8) + 32 * ((n0 & 255) >> 6); hx = 96; }
        transpose_item(W, Kp, N, WT, 64 * kb, n0, dst, hx, kgain, scr, F.lane);
    }
}
__device__ __forceinline__ void modnorm_rows(const Frame& F, const float* X, const float* g, const float* shift, const float* scale, bf16_t* out) {
    for (int m = F.gw; m < MT; m += F.NGW) {
        const int b = m >> 12;
        const f32x4* xr = (const f32x4*)(X + (size_t)m * DM) + F.lane;
        f32x4 v[8]; float s = 0.f;
#pragma unroll
        for (int j = 0; j < 8; ++j) { v[j] = xr[64 * j]; s += (v[j].x * v[j].x + v[j].y * v[j].y) + (v[j].z * v[j].z + v[j].w * v[j].w); }
        const float rs = 1.0f / sqrtf(wave_sum(s) * (1.0f / DM) + EPS);
        u32x2* o8 = (u32x2*)(out + (size_t)m * DM) + F.lane;
#pragma unroll
        for (int j = 0; j < 8; ++j) { const int col = 256 * j + 4 * F.lane;
            const f32x4 gg = *(const f32x4*)(g + col), sc = *(const f32x4*)(scale + (size_t)b * 6 * DM + col), sh = *(const f32x4*)(shift + (size_t)b * 6 * DM + col);
            const f32x4 y = v[j] * rs * gg * (sc + 1.0f) + sh;
            u32x2 wv; wv.x = pk_bf16(y.x, y.y); wv.y = pk_bf16(y.z, y.w); o8[64 * j] = wv; }
    }
}
__device__ __forceinline__ void modnorm_rows_bf16(const Frame& F, const bf16_t* X, const float* g, const float* shift, const float* scale, bf16_t* out) {
    for (int m = F.gw; m < MT; m += F.NGW) {
        const int b = m >> 12;
        const u32x4* xr = (const u32x4*)(X + (size_t)m * DM) + F.lane;
        float v[4][8]; float s = 0.f;
#pragma unroll
        for (int j = 0; j < 4; ++j) { const u32x4 raw = xr[64 * j]; unpack8(raw, v[j]);
#pragma unroll
            for (int e = 0; e < 8; ++e) s += v[j][e] * v[j][e]; }
        const float rs = 1.0f / sqrtf(wave_sum(s) * (1.0f / DM) + EPS);
        u32x4* o16 = (u32x4*)(out + (size_t)m * DM) + F.lane;
#pragma unroll
        for (int j = 0; j < 4; ++j) { const int col = 512 * j + 8 * F.lane; float y[8];
#pragma unroll
            for (int hh = 0; hh < 2; ++hh) { const f32x4 gg = *(const f32x4*)(g + col + 4 * hh), sc = *(const f32x4*)(scale + (size_t)b * 6 * DM + col + 4 * hh), sh = *(const f32x4*)(shift + (size_t)b * 6 * DM + col + 4 * hh);
#pragma unroll
                for (int e = 0; e < 4; ++e) y[4 * hh + e] = v[j][4 * hh + e] * rs * gg[e] * (sc[e] + 1.0f) + sh[e]; }
            o16[64 * j] = pack8(y); }
    }
}
__device__ __forceinline__ void vtranspose(const Frame& F, const bf16_t* src, int pitch, int col0, int hstride, bf16_t* dst) {
    LAS unsigned char* T = F.lds + F.wave * 18432;
    const int lane = F.lane;
    for (int it = F.gw; it < 2048; it += F.NGW) {
        const int b = it >> 9, h = (it >> 6) & 7, sc = it & 63;
        const bf16_t* sp = src + (size_t)(b * SEQ + 64 * sc) * pitch + col0 + h * hstride;
        u32x4 rawv[16];
#pragma unroll
        for (int i = 0; i < 16; ++i) rawv[i] = *(const u32x4*)(sp + (size_t)(4 * i + (lane >> 4)) * pitch + 8 * (lane & 15));
#pragma unroll
        for (int i = 0; i < 16; ++i) { const int tok = 4 * i + (lane >> 4), ch = lane & 15;
            const u32x4 raw = rawv[i];
            const int ptok = (tok & ~12) | ((tok & 4) << 1) | ((tok & 8) >> 1);
            LAS unsigned short* tp = (LAS unsigned short*)(T + (8 * ch) * 144 + ptok * 2);
            tp[0 * 72] = (unsigned short)(raw.x & 0xffff); tp[1 * 72] = (unsigned short)(raw.x >> 16); tp[2 * 72] = (unsigned short)(raw.y & 0xffff); tp[3 * 72] = (unsigned short)(raw.y >> 16);
            tp[4 * 72] = (unsigned short)(raw.z & 0xffff); tp[5 * 72] = (unsigned short)(raw.z >> 16); tp[6 * 72] = (unsigned short)(raw.w & 0xffff); tp[7 * 72] = (unsigned short)(raw.w >> 16); }
        asm volatile("s_waitcnt lgkmcnt(0)" ::: "memory");
        bf16_t* dp = dst + (size_t)((b * 8 + h) * 128) * SEQ + 64 * sc;
#pragma unroll 4
        for (int i = 0; i < 16; ++i) { const int dv = 8 * i + (lane >> 3), c8 = lane & 7;
            const u32x4 v = *(const LAS u32x4*)(T + dv * 144 + 16 * c8);
            *(u32x4*)(dp + (size_t)dv * SEQ + 8 * c8) = v; }
        asm volatile("s_waitcnt lgkmcnt(0)" ::: "memory");
    }
}


#define XB_TMO      128
#define XB_XCNT(j)  (256  + 64 * (j))
#define XB_XSUB(j)  (1280 + 64 * (j))
#define XB_XGEN(j)  (2304 + 64 * (j))
#define XB_TOP      3328
#define XB_TOPGEN   3392
#define XCD_BAR_WORDS 3456
#define XB_SPIN_CAP (1u << 18)
__device__ __forceinline__ unsigned xb_ld(unsigned* p)              { return __hip_atomic_load(p, __ATOMIC_RELAXED, __HIP_MEMORY_SCOPE_AGENT); }
__device__ __forceinline__ unsigned xb_add(unsigned* p, unsigned v) { return __hip_atomic_fetch_add(p, v, __ATOMIC_RELAXED, __HIP_MEMORY_SCOPE_AGENT); }
__device__ __forceinline__ unsigned xb_xcc_id() { return (unsigned)__builtin_amdgcn_s_getreg((3 << 11) | 20) & 0xFu; }
#define XB_SPIN(cond, bar) do { unsigned _sp = 0; while (cond) { __builtin_amdgcn_s_sleep(1); \
    if ((++_sp & 255u) == 0u) { if (xb_ld(&(bar)[XB_TMO])) break; if (_sp > XB_SPIN_CAP) { atomicAdd(&(bar)[XB_TMO], 1u); break; } } } } while (0)
struct XcdBarrier { unsigned* bar; unsigned x; volatile LAS unsigned* st; };
__device__ __forceinline__ XcdBarrier xcd_barrier_post(unsigned* bar, volatile LAS unsigned* st) {
    XcdBarrier b; b.bar = bar; b.x = xb_xcc_id(); b.st = st;
    if (threadIdx.x == 0) (void)xb_add(&bar[XB_XCNT(b.x)], 1u);
    return b;
}
__device__ __forceinline__ void xcd_barrier_complete(unsigned* bar, unsigned x, unsigned& nloc, unsigned& nx) {
    const unsigned G = gridDim.x * gridDim.y * gridDim.z;
    unsigned sum, cnt, mine, sp = 0u;
    for (;;) {
        sum = 0u; cnt = 0u; mine = 0u;
#pragma unroll
        for (unsigned j = 0; j < 16; ++j) { const unsigned c = xb_ld(&bar[XB_XCNT(j)]); sum += c; cnt += (c > 0u) ? 1u : 0u; mine = (j == x) ? c : mine; }
        if (sum == G) break;
        __builtin_amdgcn_s_sleep(1);
        if ((++sp & 255u) == 0u) { if (xb_ld(&bar[XB_TMO])) break; if (sp > XB_SPIN_CAP) { atomicAdd(&bar[XB_TMO], 1u); break; } }
    }
    nloc = mine > 0u ? mine : 1u; nx = cnt > 0u ? cnt : 1u;
}
__device__ __forceinline__ void xcd_barrier(const XcdBarrier& b) {
    asm volatile("s_waitcnt vmcnt(0)" ::: "memory");
    __syncthreads();
    if (threadIdx.x == 0) {
        unsigned* bar = b.bar;
        __builtin_amdgcn_s_waitcnt(0);
        unsigned nloc = b.st[0], nx = b.st[1];
        if (nloc == 0u) { xcd_barrier_complete(bar, b.x, nloc, nx); b.st[0] = nloc; b.st[1] = nx; }
        const unsigned old = xb_add(&bar[XB_XSUB(b.x)], 1u);
        const unsigned gen = old / nloc;
        if (old + 1u == (gen + 1u) * nloc) {
            __builtin_amdgcn_fence(__ATOMIC_RELEASE, "agent");
            asm volatile("s_waitcnt vmcnt(0)" ::: "memory");
            const unsigned og = xb_add(&bar[XB_TOP], 1u);
            const unsigned tg = og / nx;
            if (og + 1u == (tg + 1u) * nx) xb_add(&bar[XB_TOPGEN], 1u);
            else XB_SPIN(xb_ld(&bar[XB_TOPGEN]) == tg, bar);
            __builtin_amdgcn_fence(__ATOMIC_ACQUIRE, "agent");
            xb_add(&bar[XB_XGEN(b.x)], 1u);
            asm volatile("s_waitcnt vmcnt(0)" ::: "memory");
        } else {
            XB_SPIN(xb_ld(&bar[XB_XGEN(b.x)]) == gen, bar);
            __builtin_amdgcn_fence(__ATOMIC_ACQUIRE, "agent");
            asm volatile("s_waitcnt vmcnt(0)" ::: "memory");
        }
    }
    __syncthreads();
}
constexpr int CW_BAR = 4096;
constexpr size_t CTL_ZERO_BYTES = 65536;
#define P_x ((const float*)args.in[0])
#define P_cvec ((const float*)args.in[1])
#define P_pos ((const int*)args.in[2])
#define P_w_ada ((const float*)args.in[3])
#define P_b_ada ((const float*)args.in[4])
#define P_g_norm1 ((const float*)args.in[5])
#define P_w_in ((const float*)args.in[6])
#define P_b_gate ((const float*)args.in[7])
#define P_g_q_lat ((const float*)args.in[8])
#define P_w_q_up ((const float*)args.in[9])
#define P_g_kv_lat ((const float*)args.in[10])
#define P_w_kv_up ((const float*)args.in[11])
#define P_g_q_mla ((const float*)args.in[12])
#define P_g_k_mla ((const float*)args.in[13])
#define P_w_o_mla ((const float*)args.in[14])
#define P_g_q_diff ((const float*)args.in[15])
#define P_g_k_diff ((const float*)args.in[16])
#define P_lam_q1 ((const float*)args.in[17])
#define P_lam_k1 ((const float*)args.in[18])
#define P_lam_q2 ((const float*)args.in[19])
#define P_lam_k2 ((const float*)args.in[20])
#define P_g_sub ((const float*)args.in[21])
#define P_w_o_diff ((const float*)args.in[22])
#define P_w_out ((const float*)args.in[23])
#define P_g_norm2 ((const float*)args.in[24])
#define P_w_up ((const float*)args.in[25])
#define P_conv_w ((const float*)args.in[26])
#define P_conv_b ((const float*)args.in[27])
#define P_w_down ((const float*)args.in[28])
#define P_out (args.out)
#define P_ctl ((unsigned*)(args.ws + WS_CTL))
#define P_mod ((float*)(args.ws + WS_MOD))
#define P_part ((float*)(args.ws + WS_PART))
#define P_KPE ((bf16_t*)(args.ws + WS_KPE))
#define P_WB1 ((bf16_t*)(args.ws + WS_WB1))
#define P_WQ ((bf16_t*)(args.ws + WS_WQ))
#define P_WKV ((bf16_t*)(args.ws + WS_WKV))
#define P_WOM ((bf16_t*)(args.ws + WS_WOM))
#define P_WOUT ((bf16_t*)(args.ws + WS_WOUT))
#define P_Hb ((bf16_t*)(args.ws + WS_H))
#define P_DQ ((bf16_t*)(args.ws + WS_DQ))
#define P_DK ((bf16_t*)(args.ws + WS_DK))
#define P_MIX ((bf16_t*)(args.ws + WS_MIX))
#define P_Gb ((bf16_t*)(args.ws + WS_G))
#define P_WUP ((bf16_t*)(args.ws + WS_WUP))
#define P_WDN ((bf16_t*)(args.ws + WS_WDN))
#define P_O2 ((bf16_t*)(args.ws + WS_O2))
#define P_ACT ((bf16_t*)(args.ws + WS_ACT))
#define P_SIDE ((float*)(args.ws + WS_SIDE))
#define P_X1B ((bf16_t*)(args.ws + WS_X1B))
#define P_DV ((bf16_t*)(args.ws + WS_DV))
#define P_QM ((bf16_t*)(args.ws + WS_QM))
#define P_KN ((bf16_t*)(args.ws + WS_KN))
#define P_RAWQ ((bf16_t*)(args.ws + WS_RAWQ))
#define P_RAWKV ((bf16_t*)(args.ws + WS_RAWKV))
#define P_SSQ ((float*)(args.ws + WS_SSQ))
#define P_VM ((bf16_t*)(args.ws + WS_VM))
__global__ void __launch_bounds__(NTHREADS, 2) fwd_kernel(Args args) {
    extern __shared__ __attribute__((aligned(16))) unsigned char lds_raw[];
    cg::grid_group grid = cg::this_grid();
    Frame F;
    F.lds = (LAS unsigned char*)lds_raw; F.tid = threadIdx.x; F.lane = F.tid & 63; F.wave = __builtin_amdgcn_readfirstlane(F.tid >> 6);
    F.G = gridDim.x; F.gw = blockIdx.x * NWAVES + F.wave; F.NGW = F.G * NWAVES;
    volatile LAS int* misc = (volatile LAS int*)(F.lds + MISC_OFF);
    if (F.tid < 32) misc[F.tid] = 0;
    __syncthreads();
    const XcdBarrier bar = xcd_barrier_post(P_ctl + CW_BAR, (volatile LAS unsigned*)(misc + 8));
    if (args.ph_lo < 0) grid.sync();

    const int lo = args.ph_lo, hi_ = args.ph_hi;
#ifndef PHASE_MASK
#define PHASE_MASK 0x7fff
#endif
#define IN(k) (((PHASE_MASK >> (k)) & 1) && lo <= (k) && (k) < hi_)
#define SEAM(k) do { if (IN(k) && IN((k) + 1)) xcd_barrier(bar); } while (0)
#ifndef REP_MASK
#define REP_MASK 0
#endif
#define REPS(k) ((((REP_MASK) >> (k)) & 1) ? 2 : 1)
#define PHASE(k) if (IN(k)) for (int rep = 0; rep < REPS(k); ++rep, (rep < REPS(k) ? xcd_barrier(bar) : (void)0))

    PHASE(0) {
        for (int it = blockIdx.x; it < 192; it += F.G) {
            const int e = 64 * it + F.lane, d0 = 256 * F.wave;
            float a0 = 0.f, a1 = 0.f, a2 = 0.f, a3 = 0.f;
#pragma unroll 1
            for (int dq = 0; dq < 4; ++dq) {
                float sl[4];
#pragma unroll
                for (int b = 0; b < 4; ++b) { const float cv = P_cvec[b * DM + d0 + 64 * dq + F.lane]; sl[b] = cv * sigmoidf_fast(cv); }
#pragma unroll 16
                for (int dd = 0; dd < 64; ++dd) {
                    const float wv = P_w_ada[(size_t)(d0 + 64 * dq + dd) * (6 * DM) + e];
                    a0 += wv * __shfl(sl[0], dd); a1 += wv * __shfl(sl[1], dd); a2 += wv * __shfl(sl[2], dd); a3 += wv * __shfl(sl[3], dd);
                }
            }
            LAS float* red = (LAS float*)(F.lds + 133120);
            __syncthreads();
            red[(F.wave * 4 + 0) * 64 + F.lane] = a0; red[(F.wave * 4 + 1) * 64 + F.lane] = a1; red[(F.wave * 4 + 2) * 64 + F.lane] = a2; red[(F.wave * 4 + 3) * 64 + F.lane] = a3;
            __syncthreads();
            if (F.wave < 4) { float sacc = P_b_ada[e];
#pragma unroll
                for (int w8 = 0; w8 < 8; ++w8) sacc += red[(w8 * 4 + F.wave) * 64 + F.lane];
                P_mod[F.wave * (6 * DM) + e] = sacc; }
        }
        transpose_weight(F, P_w_in, DM, 8000, P_WB1, 1);
        transpose_weight(F, P_w_q_up, 512, 1536, P_WQ, 3, 0, P_g_q_lat);
        transpose_weight(F, P_w_kv_up, 256, 2048, P_WKV, 4, 0, P_g_kv_lat);
        transpose_weight(F, P_w_o_mla, 1024, DM, P_WOM, 0, 2048);
        transpose_weight(F, P_w_o_diff, 1024, DM, P_WOM + 1024, 0, 2048);
        transpose_weight(F, P_w_out, DM, DM, P_WOUT, 0);
    }
    SEAM(0);
    PHASE(2) modnorm_rows(F, P_x, P_g_norm1, P_mod + 0 * DM, P_mod + 1 * DM, P_Hb);
    SEAM(2);
    PHASE(3) {
        pg8::Gemm g{P_Hb, P_WB1, MT, 8192, DM, DM, 0}; pg8::StaticOrder S; S.init(MT, 8192, F.G, (int)blockIdx.x);
        pg8::EpiProj E{P_Gb, P_b_gate, P_g_q_diff, P_g_k_diff, P_g_k_mla, P_pos};
        pg8::gemm_phase(F.lds, g, S, E);
    }
    SEAM(3);
    PHASE(5) {
        LAS float* xch = (LAS float*)(F.lds + 133120);
        { pg8::Gemm g{P_RAWQ, P_WQ, MT, 1536, 512, 512, 0}; pg8::StaticOrder S; S.init(MT, 1536, F.G, (int)blockIdx.x); pg8::EpiQ E{P_QM, P_SSQ, P_g_q_mla, P_pos, xch}; pg8::gemm_phase(F.lds, g, S, E); }
        { pg8::Gemm g{P_RAWKV, P_WKV, MT, 2048, 256, 256, 0}; pg8::StaticOrder S; S.init(MT, 2048, F.G, (int)blockIdx.x); pg8::EpiKV E{P_KN, P_VM, P_SSQ, P_g_k_mla, xch}; pg8::gemm_phase(F.lds, g, S, E); }
    }
    SEAM(5);
    PHASE(7) {
        float lam;
        { const float a = wave_sum(P_lam_q1[F.lane] * P_lam_k1[F.lane]), b = wave_sum(P_lam_q2[F.lane] * P_lam_k2[F.lane]); lam = expf(a) - expf(b) + LAMBDA_INIT; }
        const int lane = F.lane, r32 = lane & 31, hi = lane >> 5, w = F.wave;
        for (;;) {
            if (F.tid == 0) misc[0] = (int)__hip_atomic_fetch_add(P_ctl, 1u, __ATOMIC_RELAXED, __HIP_MEMORY_SCOPE_AGENT);
            __syncthreads();
            const int uidx = misc[0] - rep * (1024 + F.G);
            __syncthreads();
            if (uidx >= 1024) break;
            const int qb = 15 - (uidx >> 6), within = uidx & 63, kind = within >> 5, bh = within & 31, b = bh >> 3, h = bh & 7;
            const int q0 = 256 * qb; const size_t row0 = (size_t)b * SEQ; const size_t mrow = row0 + q0 + 32 * w + r32;
            f32x16 o[4]; float l;
            if (kind == 1) {
                att::attn_tiles<192>(P_QM + row0 * 1536 + 192 * h, 1536, P_KN + row0 * 1024 + 128 * h, 1024, P_KPE + row0 * 64, P_VM + row0 * 1024 + 128 * h, 1024, q0, F.lds, o, l);
                const float inv = 1.0f / l;
#pragma unroll
                for (int db = 0; db < 4; ++db)
#pragma unroll
                    for (int g = 0; g < 4; ++g) { u32x2 wv; wv.x = pk_bf16(o[db][4 * g] * inv, o[db][4 * g + 1] * inv); wv.y = pk_bf16(o[db][4 * g + 2] * inv, o[db][4 * g + 3] * inv);
                        *(u32x2*)(P_O2 + mrow * DM + 128 * h + 32 * db + 8 * g + 4 * hi) = wv; }
            } else {
                const bf16_t* Vt = P_DV + row0 * 1024 + 128 * h;
                att::attn_tiles<64>(P_DQ + row0 * 1024 + 128 * h, 1024, P_DK + row0 * 1024 + 128 * h, 1024, nullptr, Vt, 1024, q0, F.lds, o, l);
                LAS unsigned* stash = (LAS unsigned*)(F.lds + att::Cfg<64>::TOTAL) + F.tid;
                { const float inv = 1.0f / l;
#pragma unroll
                  for (int db = 0; db < 4; ++db)
#pragma unroll
                      for (int g = 0; g < 4; ++g) { stash[(db * 8 + g * 2) * 512] = pk_bf16(o[db][4 * g] * inv, o[db][4 * g + 1] * inv); stash[(db * 8 + g * 2 + 1) * 512] = pk_bf16(o[db][4 * g + 2] * inv, o[db][4 * g + 3] * inv); } }
                att::attn_tiles<64>(P_DQ + row0 * 1024 + 128 * h + 64, 1024, P_DK + row0 * 1024 + 128 * h + 64, 1024, nullptr, Vt, 1024, q0, F.lds, o, l);
                const float inv2 = lam / l; float ss = 0.f;
#pragma unroll
                for (int db = 0; db < 4; ++db)
#pragma unroll
                    for (int g = 0; g < 4; ++g) {
                        const unsigned sx = stash[(db * 8 + g * 2) * 512], sy = stash[(db * 8 + g * 2 + 1) * 512];
                        const float d0 = bf_lo(sx) - inv2 * o[db][4 * g], d1 = bf_hi(sx) - inv2 * o[db][4 * g + 1];
                        const float d2 = bf_lo(sy) - inv2 * o[db][4 * g + 2], d3 = bf_hi(sy) - inv2 * o[db][4 * g + 3];
                        o[db][4 * g] = d0; o[db][4 * g + 1] = d1; o[db][4 * g + 2] = d2; o[db][4 * g + 3] = d3; ss += (d0 * d0 + d1 * d1) + (d2 * d2 + d3 * d3); }
                ss += __shfl_xor(ss, 32);
                const float rs = (1.0f - LAMBDA_INIT) / sqrtf(ss * (1.0f / 128.0f) + EPS);
#pragma unroll
                for (int db = 0; db < 4; ++db)
#pragma unroll
                    for (int g = 0; g < 4; ++g) { const int dv = 32 * db + 8 * g + 4 * hi; const f32x4 gs = *(const f32x4*)(P_g_sub + dv);
                        u32x2 wv; wv.x = pk_bf16(o[db][4 * g] * rs * gs.x, o[db][4 * g + 1] * rs * gs.y); wv.y = pk_bf16(o[db][4 * g + 2] * rs * gs.z, o[db][4 * g + 3] * rs * gs.w);
                        *(u32x2*)(P_O2 + mrow * DM + 1024 + 128 * h + dv) = wv; }
            }
        }
    }
    SEAM(7);
    PHASE(8) { pg8::Gemm g{P_O2, P_WOM, MT, DM, 1024, 2048, 2048}; pg8::StaticOrder S; S.init(MT, DM, F.G, (int)blockIdx.x); pg8::EpiGate<false> E{P_MIX, nullptr, P_Gb + (size_t)MT * 2048, 0}; pg8::RatioHook Hk{P_Gb};
        pg8::gemm_phase<pg8::EpiGate<false>, true, pg8::RatioHook>(F.lds, g, S, E, Hk); }
    SEAM(8);
    PHASE(10) { pg8::Gemm g{P_MIX, P_WOUT, MT, DM, DM, DM, 0}; pg8::StaticOrder S; S.init(MT, DM, F.G, (int)blockIdx.x); pg8::EpiRes1 E{P_x, P_X1B, P_mod + 2 * DM}; pg8::gemm_phase(F.lds, g, S, E); }
    SEAM(10);
    PHASE(11) {
        modnorm_rows_bf16(F, P_X1B, P_g_norm2, P_mod + 3 * DM, P_mod + 4 * DM, P_Hb);
        transpose_weight(F, P_w_up, DM, NUP, P_WUP, 2);
        transpose_weight(F, P_w_down, DFF, DM, P_WDN, 0);
    }
    SEAM(11);
    PHASE(12) { pg8::Gemm g{P_Hb, P_WUP, MT, NUP, DM, DM, 0}; pg8::StaticOrder S; S.init(MT, NUP, F.G, (int)blockIdx.x); pg8::EpiConv E{P_ACT, P_SIDE, P_conv_w, P_conv_b}; pg8::gemm_phase(F.lds, g, S, E); }
    SEAM(12);
    PHASE(13) {
        for (int i = blockIdx.x * NTHREADS + F.tid; i < 256 * 2 * (DFF / 4); i += F.G * NTHREADS) {
            const int c = (i % (DFF / 4)) * 4, j = (i / (DFF / 4)) & 1, seg = i / (2 * (DFF / 4));
            const bool hasprev = (seg & 63) != 0;
            const float* sp = P_SIDE + (size_t)seg * 4 * NUP; const float* pp = P_SIDE + (size_t)(seg - 1) * 4 * NUP;
            const f32x4 z = (f32x4){0.f, 0.f, 0.f, 0.f};
            f32x4 a;
            f32x4 y[2];
#pragma unroll
            for (int hlf = 0; hlf < 2; ++hlf) {
                const int cc = c + hlf * DFF;
                const f32x4 ut = *(const f32x4*)(sp + (size_t)j * NUP + cc);
                const f32x4 u1 = j ? *(const f32x4*)(sp + cc) : (hasprev ? *(const f32x4*)(pp + (size_t)3 * NUP + cc) : z);
                const f32x4 u2 = hasprev ? *(const f32x4*)(pp + (size_t)(j ? 3 : 2) * NUP + cc) : z;
                const f32x4 w0 = *(const f32x4*)(P_conv_w + cc), w1 = *(const f32x4*)(P_conv_w + NUP + cc), w2 = *(const f32x4*)(P_conv_w + 2 * NUP + cc), bb = *(const f32x4*)(P_conv_b + cc);
                y[hlf] = bb + w2 * ut + w1 * u1 + w0 * u2;
            }
#pragma unroll
            for (int q = 0; q < 4; ++q) a[q] = y[0][q] * y[1][q] * sigmoidf_fast(y[1][q]);
            u32x2 wv; wv.x = pk_bf16(a[0], a[1]); wv.y = pk_bf16(a[2], a[3]);
            *(u32x2*)(P_ACT + ((size_t)seg * 64 + j) * DFF + c) = wv;
        }
    }
    SEAM(13);
    PHASE(14) { pg8::Gemm g{P_ACT, P_WDN, MT, DM, DFF, DFF, 0}; pg8::StaticOrder S; S.init(MT, DM, F.G, (int)blockIdx.x); pg8::EpiRes2 E{P_X1B, P_out, P_mod + 5 * DM}; pg8::gemm_phase(F.lds, g, S, E); }
#undef IN
#undef SEAM
}

#undef P_x
#undef P_cvec
#undef P_pos
#undef P_w_ada
#undef P_b_ada
#undef P_g_norm1
#undef P_w_in
#undef P_b_gate
#undef P_g_q_lat
#undef P_w_q_up
#undef P_g_kv_lat
#undef P_w_kv_up
#undef P_g_q_mla
#undef P_g_k_mla
#undef P_w_o_mla
#undef P_g_q_diff
#undef P_g_k_diff
#undef P_lam_q1
#undef P_lam_k1
#undef P_lam_q2
#undef P_lam_k2
#undef P_g_sub
#undef P_w_o_diff
#undef P_w_out
#undef P_g_norm2
#undef P_w_up
#undef P_conv_w
#undef P_conv_b
#undef P_w_down
#undef P_out
#undef P_ctl
#undef P_mod
#undef P_part
#undef P_KPE
#undef P_WB1
#undef P_WQ
#undef P_WKV
#undef P_WOM
#undef P_WOUT
#undef P_Hb
#undef P_DQ
#undef P_DK
#undef P_MIX
#undef P_Gb
#undef P_WUP
#undef P_WDN
#undef P_O2
#undef P_ACT
#undef P_SIDE
#undef P_X1B
#undef P_DV
#undef P_QM
#undef P_KN
#undef P_RAWQ
#undef P_RAWKV
#undef P_SSQ
#undef P_VM
#ifndef N_LAUNCHES
#define N_LAUNCHES 1
#endif
constexpr int N_PHASES = 15;

extern "C" void kernel_launch(void* const* d_in, const int* in_sizes, int n_in, void* d_out, int out_size, void* d_ws, size_t ws_size, hipStream_t stream) {
    static int grid = 0;
    if (grid == 0) {
        if (n_in != 29 || in_sizes[0] != MT * DM || out_size != MT * DM || ws_size < WS_END) {
            fprintf(stderr, "kernel_launch: unexpected shapes: n_in %d in0 %d out %d ws %zu (need %zu)\n", n_in, n_in > 0 ? in_sizes[0] : -1, out_size, ws_size, (size_t)WS_END); grid = -1; return; }
        int dev = 0, cus = 0, per_cu = 0;
        (void)hipGetDevice(&dev); (void)hipDeviceGetAttribute(&cus, hipDeviceAttributeMultiprocessorCount, dev);
        if (hipFuncSetAttribute((const void*)fwd_kernel, hipFuncAttributeMaxDynamicSharedMemorySize, LDS_BYTES) != hipSuccess) { fprintf(stderr, "kernel_launch: hipFuncSetAttribute failed\n"); grid = -1; return; }
        if (hipOccupancyMaxActiveBlocksPerMultiprocessor(&per_cu, (const void*)fwd_kernel, NTHREADS, LDS_BYTES) != hipSuccess || per_cu < 1) { fprintf(stderr, "kernel_launch: occupancy query says %d blocks per CU\n", per_cu); per_cu = 1; }
        (void)hipGetLastError();
        grid = cus * 1;
        if (grid <= 0) grid = 256;
    }
    if (grid < 0) return;
    if (hipMemsetAsync((char*)d_ws + WS_CTL, 0, CTL_ZERO_BYTES, stream) != hipSuccess) { fprintf(stderr, "kernel_launch: hipMemsetAsync failed\n"); return; }
    Args a{};
    for (int i = 0; i < 29; ++i) a.in[i] = d_in[i];
    a.out = (float*)d_out; a.ws = (unsigned char*)d_ws;
#if N_LAUNCHES == 1
    a.ph_lo = 0; a.ph_hi = N_PHASES;
    void* kargs[] = {&a};
    hipError_t e = hipLaunchCooperativeKernel((const void*)fwd_kernel, dim3(grid), dim3(NTHREADS), kargs, LDS_BYTES, stream);
    if (e != hipSuccess) fprintf(stderr, "kernel_launch: cooperative launch failed: %s (grid %d)\n", hipGetErrorString(e), grid);
#else
    for (int p = 0; p < N_PHASES; ++p) {
        a.ph_lo = p; a.ph_hi = p + 1;
        void* kargs[] = {&a};
        hipError_t e = hipLaunchCooperativeKernel((const void*)fwd_kernel, dim3(grid), dim3(NTHREADS), kargs, LDS_BYTES, stream);
        if (e != hipSuccess) { fprintf(stderr, "kernel_launch: launch %d failed: %s\n", p, hipGetErrorString(e)); break; }
    }
#endif
}
```

```cpp
#include <hip/hip_runtime.h>
#include <hip/hip_cooperative_groups.h>
#include <cstdio>
#include <cstdint>
namespace cg = cooperative_groups;

#define LAS __attribute__((address_space(3)))
typedef unsigned short bf16_t;
typedef short bf16x8 __attribute__((ext_vector_type(8)));
typedef float f32x4 __attribute__((ext_vector_type(4)));
typedef float f32x16 __attribute__((ext_vector_type(16)));
typedef unsigned u32x4 __attribute__((ext_vector_type(4)));
typedef unsigned u32x2 __attribute__((ext_vector_type(2)));

constexpr int NB = 4, SEQ = 4096, DM = 2048, MT = NB * SEQ;
constexpr int DFF = 5632, NUP = 2 * DFF;
constexpr int R_KVL = 512, R_KPE = 768, R_DQ = 832, R_DK = 1856, R_DV = 2880, R_END = 3904;
constexpr int RP = 4096;
constexpr float EPS = 1e-6f;
constexpr float LOG2E = 1.4426950408889634f;
constexpr float QS_MLA = 0.07216878364870322f * LOG2E;
constexpr float QS_DIFF = 0.125f * LOG2E;
constexpr float LAMBDA_INIT = 0.2f;

constexpr size_t MiB = 1u << 20;
constexpr size_t WS_CTL = 0, WS_MOD = 256 * 1024, WS_PART = 1 * MiB, WS_KPE = 8 * MiB;
constexpr size_t WS_WB1 = 10 * MiB;
constexpr size_t WS_WQ = 42 * MiB, WS_WKV = 43 * MiB + 512 * 1024;
constexpr size_t WS_WOM = 45 * MiB, WS_WOD = 49 * MiB, WS_WOUT = 53 * MiB;
constexpr size_t WS_H = 61 * MiB, WS_O2 = 61 * MiB;
constexpr size_t WS_G = 125 * MiB, WS_WUP = 125 * MiB, WS_WDN = 169 * MiB;
constexpr size_t WS_DQ = 253 * MiB, WS_DK = 285 * MiB, WS_RAWQ = 317 * MiB, WS_RAWKV = 333 * MiB, WS_SSQ = 341 * MiB, WS_VM = 349 * MiB, WS_MIX = 253 * MiB, WS_ACT = 253 * MiB, WS_SIDE = 8 * MiB, WS_X1B = 429 * MiB;
constexpr size_t WS_DV = 381 * MiB, WS_QM = 413 * MiB, WS_KN = 461 * MiB;
constexpr size_t WS_END = 512 * MiB;

__device__ __forceinline__ unsigned pk_bf16(float lo, float hi) {
    typedef float f2 __attribute__((ext_vector_type(2))); typedef __bf16 b2 __attribute__((ext_vector_type(2)));
    f2 v = {lo, hi}; b2 b = __builtin_convertvector(v, b2); return __builtin_bit_cast(unsigned, b);
}
__device__ __forceinline__ float bf_lo(unsigned u) { return __uint_as_float(u << 16); }
__device__ __forceinline__ float bf_hi(unsigned u) { return __uint_as_float(u & 0xffff0000u); }
__device__ __forceinline__ void unpack8(const u32x4 r, float (&v)[8]) {
    v[0] = bf_lo(r.x); v[1] = bf_hi(r.x); v[2] = bf_lo(r.y); v[3] = bf_hi(r.y); v[4] = bf_lo(r.z); v[5] = bf_hi(r.z); v[6] = bf_lo(r.w); v[7] = bf_hi(r.w);
}
__device__ __forceinline__ u32x4 pack8(const float (&v)[8]) { u32x4 r; r.x = pk_bf16(v[0], v[1]); r.y = pk_bf16(v[2], v[3]); r.z = pk_bf16(v[4], v[5]); r.w = pk_bf16(v[6], v[7]); return r; }
__device__ __forceinline__ float sigmoidf_fast(float x) { return __builtin_amdgcn_rcpf(1.0f + __builtin_amdgcn_exp2f(-x * LOG2E)); }
__device__ __forceinline__ float wave_sum(float v) {
#pragma unroll
    for (int o = 1; o < 64; o <<= 1) v += __shfl_xor(v, o);
    return v;
}
__device__ __forceinline__ void rope_cs(int pos, int i, float& cs, float& sn) {
    const float inv_freq = __builtin_amdgcn_exp2f(-(float)i * (13.287712379549449f / 32.0f));
    const float ang = (float)pos * inv_freq;
    const float n = rintf(ang * 0.15915494309189535f);
    float r = fmaf(-n, 6.2831854820251465f, ang);
    r = fmaf(-n, -1.7484555e-7f, r);
    const float rev = r * 0.15915494309189535f;
    cs = __builtin_amdgcn_cosf(rev); sn = __builtin_amdgcn_sinf(rev);
}

__device__ __forceinline__ float rope_invf(int i) { return __builtin_amdgcn_exp2f(-(float)i * (13.287712379549449f / 32.0f)); }
__device__ __forceinline__ void rope_cs2(float posf, float invf, float& cs, float& sn) {
    const float ang = posf * invf;
    const float n = rintf(ang * 0.15915494309189535f);
    float r = fmaf(-n, 6.2831854820251465f, ang);
    r = fmaf(-n, -1.7484555e-7f, r);
    const float rev = r * 0.15915494309189535f;
    cs = __builtin_amdgcn_cosf(rev); sn = __builtin_amdgcn_sinf(rev);
}
#define EPI_LDS_BAR() do { asm volatile("s_waitcnt lgkmcnt(0)" ::: "memory"); __builtin_amdgcn_s_barrier(); asm volatile("" ::: "memory"); } while (0)

namespace pg8 {
constexpr int BM = 256, BK = 64, HALF = 128, HTB = HALF * BK * 2, STAGE_BYTES = 8 * HTB, NXCD = 8, WGM = 8;
__host__ __device__ __forceinline__ int lds_byte(int r, int c) { const int st = (r >> 4) * 2 + (c >> 5), rr = r & 15, cc = c & 31, ob = rr * 64 + cc * 2; return st * 1024 + (ob ^ (((ob >> 9) & 1) << 5)); }
__host__ __device__ __forceinline__ void stage_rc(int b, int& R, int& C) { const int st = b / 1024, sb = b % 1024, swz = sb ^ (((sb >> 9) & 1) << 5); R = (st >> 1) * 16 + swz / 64; C = (st & 1) * 32 + (swz % 64) / 2; }
__host__ __device__ __forceinline__ int perm32(int rho) { const int n = rho >> 4, i = rho & 15; return 8 * (i >> 2) + 4 * n + (i & 3); }

struct Unit { int pm, pn; };
struct Gemm { const bf16_t* A; const bf16_t* Bt; int M, N, K, lda, ldb; };

struct StaticOrder {
    int nM, nN, nwg, G, c;
    __device__ void init(int M, int N, int G_, int c_) { nM = M / BM; nN = N / BM; nwg = nM * nN; G = G_; c = c_; }
    __device__ bool next(int i, Unit& u) const {
        const long L = (long)i * G + c; if (L >= nwg) return false;
        int wgid = (int)L; { const int q = nwg / NXCD, r = nwg % NXCD, xcd = wgid % NXCD, off = wgid / NXCD; wgid = (xcd < r ? xcd * (q + 1) : r * (q + 1) + (xcd - r) * q) + off; }
        const int nig = WGM * nN, gid = wgid / nig, fm = gid * WGM, gsz = (nM - fm) < WGM ? (nM - fm) : WGM;
        u.pm = fm + ((wgid % nig) % gsz); u.pn = (wgid % nig) / gsz; return true;
    }
};


struct EpiProj {
    bf16_t* G;
    const float* bgate; const float* gqd; const float* gkd; const float* gkm; const int* pos;
    __device__ __forceinline__ void operator()(const f32x4 (&acc)[2][2][4][2], const Unit& u, int wr, int wc, int fr, int fq) const {
        const int row0 = u.pm * BM + wr * 64 + fr; const int pn = u.pn;
        unsigned char* const wsb = (unsigned char*)G - WS_G;
        bf16_t* const DV = (bf16_t*)(wsb + WS_DV); bf16_t* const RAWQ = (bf16_t*)(wsb + WS_RAWQ); bf16_t* const RAWKV = (bf16_t*)(wsb + WS_RAWKV); float* const SSQ = (float*)(wsb + WS_SSQ);
        bf16_t* const DQ = (bf16_t*)(wsb + WS_DQ); bf16_t* const DK = (bf16_t*)(wsb + WS_DK); bf16_t* const KPE = (bf16_t*)(wsb + WS_KPE);
        if (pn < 16) {
            const int ch0 = pn * 128 + wc * 32 + 8 * fq;
            bf16_t* const gr_ = G;
#pragma unroll
            for (int ai = 0; ai < 2; ++ai)
#pragma unroll
                for (int m = 0; m < 4; ++m) { const size_t off = (size_t)(row0 + ai * HALF + m * 16) * 2048 + ch0; float rr[8], gg[8];
#pragma unroll
                    for (int n = 0; n < 2; ++n) { const f32x4 ba = *(const f32x4*)(bgate + ch0 + 4 * n), bb = *(const f32x4*)(bgate + 2048 + ch0 + 4 * n);
#pragma unroll
                        for (int j = 0; j < 4; ++j) { const float ea = __builtin_amdgcn_exp2f(-(acc[ai][0][m][n][j] + ba[j]) * LOG2E), eb = __builtin_amdgcn_exp2f(-(acc[ai][1][m][n][j] + bb[j]) * LOG2E);
                            gg[4 * n + j] = __builtin_amdgcn_rcpf(1.0f + eb); rr[4 * n + j] = (1.0f + eb) * __builtin_amdgcn_rcpf(1.0f + ea); } }
                    *(u32x4*)(gr_ + off) = pack8(rr); *(u32x4*)(gr_ + (size_t)MT * 2048 + off) = pack8(gg);
                    asm volatile("" ::: "memory"); }
        } else if (pn < 23) {
            const bool gate = false;
            bf16_t* const p0 = G; bf16_t* const p1 = DV; bf16_t* const p2 = RAWQ; bf16_t* const p3 = RAWKV;
            bf16_t* base = pn < 16 ? p0 : (pn < 20 ? p1 : (pn < 22 ? p2 : p3));
            const int colt = pn < 16 ? pn * BM : (pn < 20 ? (pn - 16) * BM : (pn < 22 ? (pn - 20) * BM : 0));
            const int psh = pn < 16 ? 12 : (pn < 20 ? 10 : (pn < 22 ? 9 : 8));
            const int col0 = colt + wc * 32 + 8 * fq;
            f32x4 bv[2][2];
#pragma unroll
            for (int bj = 0; bj < 2; ++bj)
#pragma unroll
                for (int n = 0; n < 2; ++n) bv[bj][n] = gate ? *(const f32x4*)(bgate + col0 + bj * HALF + 4 * n) : (f32x4){0.f, 0.f, 0.f, 0.f};
#pragma unroll
            for (int ai = 0; ai < 2; ++ai)
#pragma unroll
                for (int m = 0; m < 4; ++m) { const int row = row0 + ai * HALF + m * 16; bf16_t* rowp = base + ((size_t)row << psh) + col0; float ss = 0.f;
#pragma unroll
                    for (int bj = 0; bj < 2; ++bj) { f32x4 v0 = acc[ai][bj][m][0] + bv[bj][0], v1 = acc[ai][bj][m][1] + bv[bj][1];
                        if (gate) {
#pragma unroll
                            for (int j = 0; j < 4; ++j) { v0[j] = sigmoidf_fast(v0[j]); v1[j] = sigmoidf_fast(v1[j]); } }
                        ss += (v0[0] * v0[0] + v0[1] * v0[1]) + (v0[2] * v0[2] + v0[3] * v0[3]) + (v1[0] * v1[0] + v1[1] * v1[1]) + (v1[2] * v1[2] + v1[3] * v1[3]);
                        u32x4 w; w.x = pk_bf16(v0[0], v0[1]); w.y = pk_bf16(v0[2], v0[3]); w.z = pk_bf16(v1[0], v1[1]); w.w = pk_bf16(v1[2], v1[3]);
                        *(u32x4*)(rowp + bj * HALF) = w; }
                    if (pn >= 20) { ss += __shfl_xor(ss, 16); ss += __shfl_xor(ss, 32); if (fq == 0) SSQ[(size_t)row * 12 + (pn - 20) * 4 + wc] = ss; } }
        } else {
            const bool isq = pn < 27, iskpe = pn == 31;
            if (iskpe && wc != 0) return;
            const float* const ga = gqd; const float* const gb = gkd; const float* const gc = gkm + 128;
            const float* gp = isq ? ga : (iskpe ? gc : gb);
            bf16_t* const o0 = DQ; bf16_t* const o1 = DK; bf16_t* const o2 = KPE;
            bf16_t* ob = isq ? o0 : (iskpe ? o2 : o1);
            const int osh = iskpe ? 6 : 10, grp = iskpe ? 0 : 4 * (pn - (isq ? 23 : 27)) + wc;
            const float qs = isq ? QS_DIFF : 1.0f;
            f32x4 g0[2], g1[2]; float invf[2][4];
#pragma unroll
            for (int n = 0; n < 2; ++n) { g0[n] = *(const f32x4*)(gp + 8 * fq + 4 * n); g1[n] = *(const f32x4*)(gp + 32 + 8 * fq + 4 * n);
#pragma unroll
                for (int j = 0; j < 4; ++j) invf[n][j] = rope_invf(8 * fq + 4 * n + j); }
#pragma unroll
            for (int ai = 0; ai < 2; ++ai)
#pragma unroll
                for (int m = 0; m < 4; ++m) { const int row = row0 + ai * HALF + m * 16; const float posf = (float)pos[row];
                    float ss = 0.f;
#pragma unroll
                    for (int bj = 0; bj < 2; ++bj)
#pragma unroll
                        for (int n = 0; n < 2; ++n) { const f32x4 x = acc[ai][bj][m][n]; ss += (x[0] * x[0] + x[1] * x[1]) + (x[2] * x[2] + x[3] * x[3]); }
                    ss += __shfl_xor(ss, 16); ss += __shfl_xor(ss, 32);
                    const float rs = qs / sqrtf(ss * (1.0f / 64.0f) + EPS);
                    float lo[8], hi8[8];
#pragma unroll
                    for (int n = 0; n < 2; ++n)
#pragma unroll
                        for (int j = 0; j < 4; ++j) { float cs, sn; rope_cs2(posf, invf[n][j], cs, sn);
                            const float a = acc[ai][0][m][n][j] * g0[n][j], b = acc[ai][1][m][n][j] * g1[n][j];
                            lo[4 * n + j] = rs * (a * cs - b * sn); hi8[4 * n + j] = rs * (b * cs + a * sn); }
                    bf16_t* op = ob + ((size_t)row << osh) + 64 * grp + 8 * fq;
                    *(u32x4*)op = pack8(lo); *(u32x4*)(op + 32) = pack8(hi8); }
        }
    }
};
struct EpiQ {
    bf16_t* QM; const float* SSQ; const float* gq; const int* pos; LAS float* xch;
    __device__ __forceinline__ void operator()(const f32x4 (&acc)[2][2][4][2], const Unit& u, int wr, int wc, int fr, int fq) const {
        const int row0 = u.pm * BM + wr * 64 + fr; const int hb = u.pn / 3, tt = u.pn % 3;
#define EPI_SS16(dst) do { float ss_ = 0.f; _Pragma("unroll") for (int bj = 0; bj < 2; ++bj) _Pragma("unroll") for (int n = 0; n < 2; ++n) { const f32x4 x = acc[ai][bj][m][n]; ss_ += (x[0] * x[0] + x[1] * x[1]) + (x[2] * x[2] + x[3] * x[3]); } \
        ss_ += __shfl_xor(ss_, 16); ss_ += __shfl_xor(ss_, 32); dst = ss_; } while (0)
#define EPI_RQ(dst, row) do { const float* sp_ = SSQ + (size_t)(row) * 12; const f32x4 a_ = *(const f32x4*)sp_, b_ = *(const f32x4*)(sp_ + 4); \
        dst = 1.0f / sqrtf(((a_[0] + a_[1]) + (a_[2] + a_[3]) + (b_[0] + b_[1]) + (b_[2] + b_[3])) * (1.0f / 512.0f) + EPS); } while (0)
        if (tt < 2) {
            const int h = 4 * hb + 2 * tt + (wc >> 1), gg = wc & 1;
#pragma unroll
            for (int ai = 0; ai < 2; ++ai)
#pragma unroll
                for (int m = 0; m < 4; ++m) { float s1; EPI_SS16(s1); if (fq == 0) xch[(ai * HALF + wr * 64 + m * 16 + fr) * 4 + wc] = s1; }
            EPI_LDS_BAR();
            f32x4 g0[2], g1[2];
#pragma unroll
            for (int n = 0; n < 2; ++n) { g0[n] = *(const f32x4*)(gq + 64 * gg + 8 * fq + 4 * n); g1[n] = *(const f32x4*)(gq + 64 * gg + 32 + 8 * fq + 4 * n); }
#pragma unroll
            for (int ai = 0; ai < 2; ++ai)
#pragma unroll
                for (int m = 0; m < 4; ++m) { const int row = row0 + ai * HALF + m * 16; float r; EPI_RQ(r, row);
                    const LAS float* xr = xch + (ai * HALF + wr * 64 + m * 16 + fr) * 4 + (wc & 2);
                    const float tot = xr[0] + xr[1];
                    const float f = QS_MLA * r / sqrtf(r * r * tot * (1.0f / 128.0f) + EPS);
                    float lo[8], hi8[8];
#pragma unroll
                    for (int n = 0; n < 2; ++n)
#pragma unroll
                        for (int j = 0; j < 4; ++j) { lo[4 * n + j] = f * acc[ai][0][m][n][j] * g0[n][j]; hi8[4 * n + j] = f * acc[ai][1][m][n][j] * g1[n][j]; }
                    bf16_t* op = QM + (size_t)row * 1536 + 192 * h + 64 * gg + 8 * fq;
                    *(u32x4*)op = pack8(lo); *(u32x4*)(op + 32) = pack8(hi8); }
        } else {
            const int h = 4 * hb + wc;
            f32x4 g0[2], g1[2]; float invf[2][4];
#pragma unroll
            for (int n = 0; n < 2; ++n) { g0[n] = *(const f32x4*)(gq + 128 + 8 * fq + 4 * n); g1[n] = *(const f32x4*)(gq + 160 + 8 * fq + 4 * n);
#pragma unroll
                for (int j = 0; j < 4; ++j) invf[n][j] = rope_invf(8 * fq + 4 * n + j); }
#pragma unroll
            for (int ai = 0; ai < 2; ++ai)
#pragma unroll
                for (int m = 0; m < 4; ++m) { const int row = row0 + ai * HALF + m * 16; float r; EPI_RQ(r, row); const float posf = (float)pos[row];
                    float ss1; EPI_SS16(ss1);
                    const float f = QS_MLA * r / sqrtf(r * r * ss1 * (1.0f / 64.0f) + EPS);
                    float lo[8], hi8[8];
#pragma unroll
                    for (int n = 0; n < 2; ++n)
#pragma unroll
                        for (int j = 0; j < 4; ++j) { float cs, sn; rope_cs2(posf, invf[n][j], cs, sn);
                            const float a = acc[ai][0][m][n][j] * g0[n][j], b = acc[ai][1][m][n][j] * g1[n][j];
                            lo[4 * n + j] = f * (a * cs - b * sn); hi8[4 * n + j] = f * (b * cs + a * sn); }
                    bf16_t* op = QM + (size_t)row * 1536 + 192 * h + 128 + 8 * fq;
                    *(u32x4*)op = pack8(lo); *(u32x4*)(op + 32) = pack8(hi8); }
        }
    }
};
struct EpiKV {
    bf16_t* KN; bf16_t* VM; const float* SSQ; const float* gk; LAS float* xch;
    __device__ __forceinline__ void operator()(const f32x4 (&acc)[2][2][4][2], const Unit& u, int wr, int wc, int fr, int fq) const {
        const int row0 = u.pm * BM + wr * 64 + fr; const int h = u.pn;
#pragma unroll
        for (int ai = 0; ai < 2; ++ai)
#pragma unroll
            for (int m = 0; m < 4; ++m) { float s1; EPI_SS16(s1); if (fq == 0) xch[(ai * HALF + wr * 64 + m * 16 + fr) * 4 + wc] = s1; }
        EPI_LDS_BAR();
        const int gg = wc & 1;
        if (wc < 2) {
            f32x4 g0[2], g1[2];
#pragma unroll
            for (int n = 0; n < 2; ++n) { g0[n] = *(const f32x4*)(gk + 64 * gg + 8 * fq + 4 * n); g1[n] = *(const f32x4*)(gk + 64 * gg + 32 + 8 * fq + 4 * n); }
#pragma unroll
            for (int ai = 0; ai < 2; ++ai)
#pragma unroll
                for (int m = 0; m < 4; ++m) { const int row = row0 + ai * HALF + m * 16;
                    float r; { const f32x4 a_ = *(const f32x4*)(SSQ + (size_t)row * 12 + 8); r = 1.0f / sqrtf(((a_[0] + a_[1]) + (a_[2] + a_[3])) * (1.0f / 256.0f) + EPS); }
                    const LAS float* xr = xch + (ai * HALF + wr * 64 + m * 16 + fr) * 4 + (wc & 2);
                    const float tot = xr[0] + xr[1];
                    const float f = r / sqrtf(r * r * tot * (1.0f / 128.0f) + EPS);
                    float lo[8], hi8[8];
#pragma unroll
                    for (int n = 0; n < 2; ++n)
#pragma unroll
                        for (int j = 0; j < 4; ++j) { lo[4 * n + j] = f * acc[ai][0][m][n][j] * g0[n][j]; hi8[4 * n + j] = f * acc[ai][1][m][n][j] * g1[n][j]; }
                    bf16_t* op = KN + (size_t)row * 1024 + 128 * h + 64 * gg + 8 * fq;
                    *(u32x4*)op = pack8(lo); *(u32x4*)(op + 32) = pack8(hi8);
                    asm volatile("" ::: "memory"); }
        } else {
#pragma unroll
            for (int ai = 0; ai < 2; ++ai)
#pragma unroll
                for (int m = 0; m < 4; ++m) { const int row = row0 + ai * HALF + m * 16;
                    float r; { const f32x4 a_ = *(const f32x4*)(SSQ + (size_t)row * 12 + 8); r = 1.0f / sqrtf(((a_[0] + a_[1]) + (a_[2] + a_[3])) * (1.0f / 256.0f) + EPS); }
                    float lo[8], hi8[8];
#pragma unroll
                    for (int n = 0; n < 2; ++n)
#pragma unroll
                        for (int j = 0; j < 4; ++j) { lo[4 * n + j] = r * acc[ai][0][m][n][j]; hi8[4 * n + j] = r * acc[ai][1][m][n][j]; }
                    bf16_t* op = VM + (size_t)row * 1024 + 128 * h + 64 * gg + 8 * fq;
                    *(u32x4*)op = pack8(lo); *(u32x4*)(op + 32) = pack8(hi8);
                    asm volatile("" ::: "memory"); }
        }
    }
};
#undef EPI_SS16
#undef EPI_RQ
struct EpiPlain {
    bf16_t* O; int ldc;
    __device__ __forceinline__ void operator()(const f32x4 (&acc)[2][2][4][2], const Unit& u, int wr, int wc, int fr, int fq) const {
        const int row0 = u.pm * BM + wr * 64 + fr; const int col0 = u.pn * BM + wc * 32 + 8 * fq;
#pragma unroll
        for (int ai = 0; ai < 2; ++ai)
#pragma unroll
            for (int m = 0; m < 4; ++m) { bf16_t* rowp = O + (size_t)(row0 + ai * HALF + m * 16) * ldc + col0;
#pragma unroll
                for (int bj = 0; bj < 2; ++bj) { const f32x4 v0 = acc[ai][bj][m][0], v1 = acc[ai][bj][m][1];
                    u32x4 w; w.x = pk_bf16(v0[0], v0[1]); w.y = pk_bf16(v0[2], v0[3]); w.z = pk_bf16(v1[0], v1[1]); w.w = pk_bf16(v1[2], v1[3]);
                    *(u32x4*)(rowp + bj * HALF) = w; } }
    }
};
template <bool ADD> struct EpiGate {
    bf16_t* O; const bf16_t* Tin; const bf16_t* Gt; int gcol;
    __device__ __forceinline__ void operator()(const f32x4 (&acc)[2][2][4][2], const Unit& u, int wr, int wc, int fr, int fq) const {
        const int row0 = u.pm * BM + wr * 64 + fr; const int col0 = u.pn * BM + wc * 32 + 8 * fq;
#pragma unroll
        for (int ai = 0; ai < 2; ++ai)
#pragma unroll
            for (int m = 0; m < 4; ++m) { const size_t row = (size_t)(row0 + ai * HALF + m * 16);
#pragma unroll
                for (int bj = 0; bj < 2; ++bj) { const f32x4 v0 = acc[ai][bj][m][0], v1 = acc[ai][bj][m][1];
                    const int col = col0 + bj * HALF;
                    const u32x4 gr = *(const u32x4*)(Gt + row * DM + gcol + col); float g[8]; unpack8(gr, g);
                    float o[8];
#pragma unroll
                    for (int j = 0; j < 4; ++j) { o[j] = g[j] * v0[j]; o[4 + j] = g[4 + j] * v1[j]; }
                    if (ADD) { const u32x4 tr = *(const u32x4*)(Tin + row * DM + col); float t[8]; unpack8(tr, t);
#pragma unroll
                        for (int j = 0; j < 8; ++j) o[j] += t[j]; }
                    *(u32x4*)(O + row * DM + col) = pack8(o); } }
    }
};
struct RatioHook {
    const bf16_t* Gt;
    __device__ __forceinline__ void operator()(f32x4 (&acc)[2][2][4][2], const Unit& u, int wr, int wc, int fr, int fq) const {
        const int row0 = u.pm * BM + wr * 64 + fr; const int col0 = u.pn * BM + wc * 32 + 8 * fq;
#pragma unroll
        for (int ai = 0; ai < 2; ++ai)
#pragma unroll
            for (int m = 0; m < 4; ++m) { const bf16_t* gp = Gt + (size_t)(row0 + ai * HALF + m * 16) * 2048 + col0;
#pragma unroll
                for (int bj = 0; bj < 2; ++bj) {
                    const u32x4 ar = *(const u32x4*)(gp + bj * HALF);
                    float a[8]; unpack8(ar, a);
#pragma unroll
                    for (int j = 0; j < 4; ++j) { acc[ai][bj][m][0][j] *= a[j]; acc[ai][bj][m][1][j] *= a[4 + j]; }
                    asm volatile("" : "+v"(acc[ai][bj][m][0]), "+v"(acc[ai][bj][m][1]) :: "memory"); __builtin_amdgcn_sched_barrier(0);
                } }
    }
};
struct EpiRes1 {
    const float* base; bf16_t* out; const float* gatev;
    __device__ __forceinline__ void operator()(const f32x4 (&acc)[2][2][4][2], const Unit& u, int wr, int wc, int fr, int fq) const {
        const int row0 = u.pm * BM + wr * 64 + fr; const int col0 = u.pn * BM + wc * 32 + 8 * fq;
        const float* gp = gatev + (size_t)(u.pm >> 4) * (6 * DM);
        f32x4 gv[2][2];
#pragma unroll
        for (int bj = 0; bj < 2; ++bj)
#pragma unroll
            for (int n = 0; n < 2; ++n) gv[bj][n] = *(const f32x4*)(gp + col0 + bj * HALF + 4 * n);
#pragma unroll
        for (int ai = 0; ai < 2; ++ai)
#pragma unroll
            for (int m = 0; m < 4; ++m) { const size_t off = (size_t)(row0 + ai * HALF + m * 16) * DM + col0;
#pragma unroll
                for (int bj = 0; bj < 2; ++bj) { const f32x4 b0 = *(const f32x4*)(base + off + bj * HALF), b1 = *(const f32x4*)(base + off + bj * HALF + 4);
                    const f32x4 v0 = b0 + gv[bj][0] * acc[ai][bj][m][0], v1 = b1 + gv[bj][1] * acc[ai][bj][m][1];
                    u32x4 w; w.x = pk_bf16(v0[0], v0[1]); w.y = pk_bf16(v0[2], v0[3]); w.z = pk_bf16(v1[0], v1[1]); w.w = pk_bf16(v1[2], v1[3]);
                    *(u32x4*)(out + off + bj * HALF) = w; } }
    }
};
struct EpiRes2 {
    const bf16_t* base; float* out; const float* gatev;
    __device__ __forceinline__ void operator()(const f32x4 (&acc)[2][2][4][2], const Unit& u, int wr, int wc, int fr, int fq) const {
        const int row0 = u.pm * BM + wr * 64 + fr; const int col0 = u.pn * BM + wc * 32 + 8 * fq;
        const float* gp = gatev + (size_t)(u.pm >> 4) * (6 * DM);
        f32x4 gv[2][2];
#pragma unroll
        for (int bj = 0; bj < 2; ++bj)
#pragma unroll
            for (int n = 0; n < 2; ++n) gv[bj][n] = *(const f32x4*)(gp + col0 + bj * HALF + 4 * n);
#pragma unroll
        for (int ai = 0; ai < 2; ++ai)
#pragma unroll
            for (int m = 0; m < 4; ++m) { const size_t off = (size_t)(row0 + ai * HALF + m * 16) * DM + col0;
#pragma unroll
                for (int bj = 0; bj < 2; ++bj) { const u32x4 br = *(const u32x4*)(base + off + bj * HALF); float bs[8]; unpack8(br, bs);
                    *(f32x4*)(out + off + bj * HALF) = (f32x4){bs[0], bs[1], bs[2], bs[3]} + gv[bj][0] * acc[ai][bj][m][0];
                    *(f32x4*)(out + off + bj * HALF + 4) = (f32x4){bs[4], bs[5], bs[6], bs[7]} + gv[bj][1] * acc[ai][bj][m][1]; } }
    }
};
__device__ __forceinline__ float dpp_shift1(float cur, float prev) {
    const int t = __builtin_amdgcn_update_dpp(0, __float_as_int(prev), 0x121, 0xf, 0xf, false);
    return __int_as_float(__builtin_amdgcn_update_dpp(t, __float_as_int(cur), 0x111, 0xf, 0xf, false));
}
__device__ __forceinline__ float dpp_shift2(float cur, float prev) {
    const int t = __builtin_amdgcn_update_dpp(0, __float_as_int(prev), 0x122, 0xf, 0xf, false);
    return __int_as_float(__builtin_amdgcn_update_dpp(t, __float_as_int(cur), 0x112, 0xf, 0xf, false));
}
struct EpiConv {
    bf16_t* ACT; float* SIDE; const float* cw; const float* cb;
    __device__ __forceinline__ void operator()(const f32x4 (&acc)[2][2][4][2], const Unit& u, int wr, int wc, int fr, int fq) const {
#pragma unroll
        for (int n = 0; n < 2; ++n) {
            const int ch = u.pn * 128 + wc * 32 + 8 * fq + 4 * n;
            const f32x4 w0v = *(const f32x4*)(cw + ch), w1v = *(const f32x4*)(cw + NUP + ch), w2v = *(const f32x4*)(cw + 2 * NUP + ch), bv = *(const f32x4*)(cb + ch);
            const f32x4 w0g = *(const f32x4*)(cw + DFF + ch), w1g = *(const f32x4*)(cw + NUP + DFF + ch), w2g = *(const f32x4*)(cw + 2 * NUP + DFF + ch), bg = *(const f32x4*)(cb + DFF + ch);
#pragma unroll
            for (int ai = 0; ai < 2; ++ai) {
                const int seg = u.pm * 4 + ai * 2 + wr;
#pragma unroll
                for (int m = 0; m < 4; ++m) {
                    const f32x4 uv = acc[ai][0][m][n], ug = acc[ai][1][m][n];
                    const f32x4 pv = m ? acc[ai][0][m ? m - 1 : 0][n] : (f32x4){0.f, 0.f, 0.f, 0.f};
                    const f32x4 pg = m ? acc[ai][1][m ? m - 1 : 0][n] : (f32x4){0.f, 0.f, 0.f, 0.f};
                    f32x4 a;
#pragma unroll
                    for (int j = 0; j < 4; ++j) {
                        const float s1v = dpp_shift1(uv[j], pv[j]), s2v = dpp_shift2(uv[j], pv[j]);
                        const float s1g = dpp_shift1(ug[j], pg[j]), s2g = dpp_shift2(ug[j], pg[j]);
                        const float yv = bv[j] + w2v[j] * uv[j] + w1v[j] * s1v + w0v[j] * s2v;
                        const float yg = bg[j] + w2g[j] * ug[j] + w1g[j] * s1g + w0g[j] * s2g;
                        a[j] = yv * yg * sigmoidf_fast(yg);
                    }
                    const size_t row = (size_t)seg * 64 + m * 16 + fr;
                    if (m > 0 || fr >= 2) { u32x2 w; w.x = pk_bf16(a[0], a[1]); w.y = pk_bf16(a[2], a[3]); *(u32x2*)(ACT + row * DFF + ch) = w; }
                    if (m == 0 && fr < 2) { float* sp = SIDE + ((size_t)seg * 4 + fr) * NUP + ch; *(f32x4*)sp = uv; *(f32x4*)(sp + DFF) = ug; }
                    if (m == 3 && fr >= 14) { float* sp = SIDE + ((size_t)seg * 4 + 2 + (fr - 14)) * NUP + ch; *(f32x4*)sp = uv; *(f32x4*)(sp + DFF) = ug; }
                }
            }
        }
    }
};

struct NoHook { __device__ __forceinline__ void operator()(f32x4 (&)[2][2][4][2], const Unit&, int, int, int, int) const {} };
template <class Epi, bool HOOK = false, class Hook = NoHook>
__device__ __forceinline__ void gemm_phase(LAS unsigned char* lds, const Gemm g, const StaticOrder& S, const Epi& E, const Hook& Hk = Hook()) {
    const int tid = threadIdx.x, wid = __builtin_amdgcn_readfirstlane(tid >> 6), lane = tid & 63, wr = wid >> 2, wc = wid & 3, fr = lane & 15, fq = lane >> 4;
    const int K = g.K, nt = K / BK, lda = g.lda, ldb = g.ldb ? g.ldb : g.K;
    const size_t halfoff = (size_t)K * 2;
    unsigned voffA[2], voffB[2];
#pragma unroll
    for (int i = 0; i < 2; ++i) { int R, C; stage_rc(tid * 16 + i * 8192, R, C); const int Rb = (R & ~31) + perm32(R & 31);
        voffA[i] = (unsigned)(R * lda + C) * 2u; voffB[i] = (unsigned)(Rb * ldb + C) * 2u; }
    const size_t kstep = (size_t)(BK * 2);
    const size_t hstepA = (size_t)HALF * lda * 2, hstepB = (size_t)HALF * ldb * 2;
    const size_t tstepA = 2 * hstepA, tstepB = 2 * hstepB;
    const unsigned ldsw = (unsigned)wid * 1024u;
    const int aoff = lds_byte(wr * 64 + fr, fq * 8), boff = lds_byte(wc * 32 + fr, fq * 8);
#define PG8_SA(b, h) (((b) * 2 + (h)) * HTB)
#define PG8_SB(b, h) ((4 + (b) * 2 + (h)) * HTB)
#define PG8_STAGE(bufoff, gbase, voff) do { _Pragma("unroll") for (int _i = 0; _i < 2; ++_i) \
        __builtin_amdgcn_global_load_lds((const unsigned*)((const char*)(gbase) + (voff)[_i]), (LAS unsigned*)(lds + (bufoff) + ldsw + _i * 8192), 16, 0, 0); } while (0)
#define PG8_LDA(dst, b, h) do { _Pragma("unroll") for (int m = 0; m < 4; ++m) _Pragma("unroll") for (int k = 0; k < 2; ++k) dst[m][k] = *(const LAS bf16x8*)(lds + PG8_SA(b, h) + aoff + m * 2048 + k * 1024); } while (0)
#define PG8_LDB(dst, b, h) do { _Pragma("unroll") for (int n = 0; n < 2; ++n) _Pragma("unroll") for (int k = 0; k < 2; ++k) dst[n][k] = *(const LAS bf16x8*)(lds + PG8_SB(b, h) + boff + n * 2048 + k * 1024); } while (0)
#define PG8_MMA(ai, bj, At, Bt) do { __builtin_amdgcn_s_setprio(1); _Pragma("unroll") for (int m = 0; m < 4; ++m) _Pragma("unroll") for (int n = 0; n < 2; ++n) _Pragma("unroll") for (int k = 0; k < 2; ++k) \
        acc[ai][bj][m][n] = __builtin_amdgcn_mfma_f32_16x16x32_bf16(Bt[n][k], At[m][k], acc[ai][bj][m][n], 0, 0, 0); __builtin_amdgcn_s_setprio(0); } while (0)
#define PG8_WAIT_V(n) asm volatile("s_waitcnt vmcnt(" #n ")" ::: "memory")
#define PG8_WAIT_L(n) asm volatile("s_waitcnt lgkmcnt(" #n ")" ::: "memory")
#define PG8_BAR __builtin_amdgcn_s_barrier()
#define PG8_SCHED __builtin_amdgcn_sched_barrier(0)
    Unit cur, nxt; int ui = 0;
    if (!S.next(0, cur)) return;
    f32x4 acc[2][2][4][2];
#pragma unroll
    for (int a = 0; a < 2; ++a)
#pragma unroll
        for (int b = 0; b < 2; ++b)
#pragma unroll
            for (int m = 0; m < 4; ++m)
#pragma unroll
                for (int n = 0; n < 2; ++n) acc[a][b][m][n] = (f32x4){0.f, 0.f, 0.f, 0.f};
    bf16x8 At[4][2], B0[2][2], B1[2][2];
    const char* cA = (const char*)g.A + (size_t)cur.pm * tstepA; const char* cB = (const char*)g.Bt + (size_t)cur.pn * tstepB;
    PG8_STAGE(PG8_SB(0, 0), cB, voffB); PG8_STAGE(PG8_SB(0, 1), cB + hstepB, voffB); PG8_STAGE(PG8_SA(0, 0), cA, voffA); PG8_STAGE(PG8_SA(0, 1), cA + hstepA, voffA);
    if (wr == 1) PG8_BAR;
    PG8_WAIT_V(2); PG8_BAR;
    PG8_STAGE(PG8_SB(1, 0), cB + kstep, voffB); PG8_STAGE(PG8_SA(1, 0), cA + kstep, voffA); PG8_STAGE(PG8_SB(1, 1), cB + hstepB + kstep, voffB);
    PG8_WAIT_V(6); PG8_BAR;
    for (;;) {
        const bool has_next = HOOK ? (((ui + 1) & 1) ? (nxt = cur, true) : S.next((ui + 1) >> 1, nxt)) : S.next(ui + 1, nxt);
        const size_t nho = (HOOK && ((ui + 1) & 1)) ? halfoff : 0;
        const char* nA = has_next ? (const char*)g.A + (size_t)nxt.pm * tstepA + nho : cA; const char* nB = has_next ? (const char*)g.Bt + (size_t)nxt.pn * tstepB + nho : cB;
        for (int t = 0; t < nt; t += 2) {
            const bool last = (t == nt - 2);
            const char* a1 = cA + (size_t)(t + 1) * kstep;
            const char* a2 = last ? nA : cA + (size_t)(t + 2) * kstep; const char* b2 = last ? nB : cB + (size_t)(t + 2) * kstep;
            const char* a3 = a2 + kstep; const char* b3 = b2 + kstep;
            PG8_LDB(B0, 0, 0); PG8_LDB(B1, 0, 1); PG8_SCHED; PG8_LDA(At, 0, 0); PG8_STAGE(PG8_SA(1, 1), a1 + hstepA, voffA);
            PG8_WAIT_V(8); PG8_WAIT_L(0); PG8_BAR; PG8_MMA(0, 0, At, B0); PG8_MMA(0, 1, At, B1); PG8_BAR; PG8_SCHED;
            PG8_LDA(At, 0, 1); PG8_STAGE(PG8_SB(0, 0), b2, voffB); PG8_STAGE(PG8_SB(0, 1), b2 + hstepB, voffB); PG8_STAGE(PG8_SA(0, 0), a2, voffA);
            PG8_WAIT_V(8); PG8_WAIT_L(0); PG8_BAR; PG8_MMA(1, 0, At, B0); PG8_MMA(1, 1, At, B1); PG8_BAR; PG8_SCHED;
            PG8_LDB(B0, 1, 0); PG8_LDB(B1, 1, 1); PG8_SCHED; PG8_LDA(At, 1, 0); PG8_STAGE(PG8_SA(0, 1), a2 + hstepA, voffA);
            PG8_WAIT_V(8); PG8_WAIT_L(0); PG8_BAR; PG8_MMA(0, 0, At, B0); PG8_MMA(0, 1, At, B1); PG8_BAR; PG8_SCHED;
            PG8_LDA(At, 1, 1); PG8_STAGE(PG8_SB(1, 0), b3, voffB); PG8_STAGE(PG8_SB(1, 1), b3 + hstepB, voffB); PG8_STAGE(PG8_SA(1, 0), a3, voffA);
            PG8_WAIT_V(8); PG8_WAIT_L(0); PG8_BAR; PG8_MMA(1, 0, At, B0); PG8_MMA(1, 1, At, B1); PG8_BAR; PG8_SCHED;
        }
        if (wr == 0) PG8_BAR;
        const bool half0 = HOOK && !(ui & 1);
        if (half0) Hk(acc, cur, wr, wc, fr, fq); else E(acc, cur, wr, wc, fr, fq);
        if (!has_next) break;
        { const float keep = half0 ? 1.0f : 0.0f;
#pragma unroll
        for (int a = 0; a < 2; ++a)
#pragma unroll
            for (int b = 0; b < 2; ++b)
#pragma unroll
                for (int m = 0; m < 4; ++m)
#pragma unroll
                    for (int n = 0; n < 2; ++n) { if (HOOK) acc[a][b][m][n] = acc[a][b][m][n] * keep; else acc[a][b][m][n] = (f32x4){0.f, 0.f, 0.f, 0.f}; } }
        cur = nxt; cA = nA; cB = nB; ++ui;
        if (wr == 1) PG8_BAR;
    }
    PG8_WAIT_V(0);
    PG8_BAR;
#undef PG8_SA
#undef PG8_SB
#undef PG8_STAGE
#undef PG8_LDA
#undef PG8_LDB
#undef PG8_MMA
#undef PG8_WAIT_V
#undef PG8_WAIT_L
#undef PG8_BAR
#undef PG8_SCHED
}
}

namespace att {
#define MFMA32(a, b, c) __builtin_amdgcn_mfma_f32_32x32x16_bf16((a), (b), (c), 0, 0, 0)
__device__ __forceinline__ int crow(int r, int hi) { return (r & 3) + 8 * (r >> 2) + 4 * hi; }
typedef short v4i16 __attribute__((ext_vector_type(4)));
template <int DQK> struct Cfg { static constexpr int KCH = DQK / 8, KROWB = DQK * 2, NKC = (64 * KCH) / 512, KBYTES = 64 * KROWB, VBYTES = 64 * 256, VOFF = 3 * KBYTES, TOTAL = 3 * KBYTES + 4 * VBYTES, NDMA = NKC + 2; };

template <int DQK>
__device__ __forceinline__ void attn_tiles(const bf16_t* __restrict__ Qg, int qpitch, const bf16_t* __restrict__ Kg, int kpitch, const bf16_t* __restrict__ Kpe,
                                           const bf16_t* __restrict__ Vg, int vpitch, int q0, LAS unsigned char* lds, f32x16 (&o)[4], float& l_out) {
    typedef Cfg<DQK> C;
    int tid_ = threadIdx.x; asm volatile("" : "+v"(tid_));
    const int tid = tid_, lane = tid & 63, r32 = lane & 31, hi = lane >> 5; const int w = __builtin_amdgcn_readfirstlane(tid >> 6);
    const int NT = (q0 + 256) / 64;
    const int tl = NT - 4 + (w >> 1);
    bf16x8 qf[DQK / 16];
    { const bf16_t* qrow = Qg + (size_t)(q0 + 32 * w + r32) * qpitch + 8 * hi;
#pragma unroll
      for (int ds = 0; ds < DQK / 16; ++ds) qf[ds] = *(const bf16x8*)(qrow + 16 * ds); }
    unsigned koff[C::NKC]; bool kpe_[C::NKC];
#pragma unroll
    for (int i = 0; i < C::NKC; ++i) { const int P = tid + 512 * i, kr = P / C::KCH, cp = P % C::KCH, kc = (cp & ~7) | ((cp ^ (kr >> 1)) & 7); kpe_[i] = (DQK == 192) && kc >= 16;
        koff[i] = kpe_[i] ? (unsigned)(kr * 64 + 8 * (kc - 16)) : (unsigned)(kr * kpitch + 8 * kc); }
    const unsigned voff = (unsigned)((tid >> 4) * vpitch + 8 * ((((((tid & 15) >> 1) ^ (2 * ((tid >> 4) & 3))) << 1) | (tid & 1))));
#define ATT_DMA(t) do { const bf16_t* kt_ = Kg + (size_t)(64 * (t)) * kpitch; const bf16_t* kp_ = Kpe + (size_t)(64 * (t)) * 64; const bf16_t* vt_ = Vg + (size_t)(64 * (t)) * vpitch; \
        LAS unsigned char* kb_ = lds + ((t) % 3) * C::KBYTES + w * 1024; LAS unsigned char* vb_ = lds + C::VOFF + ((t) & 3) * C::VBYTES + w * 1024; \
        _Pragma("unroll") for (int i = 0; i < C::NKC; ++i) __builtin_amdgcn_global_load_lds((const unsigned*)((kpe_[i] ? kp_ : kt_) + koff[i]), (LAS unsigned*)(kb_ + i * 8192), 16, 0, 0); \
        __builtin_amdgcn_global_load_lds((const unsigned*)(vt_ + voff), (LAS unsigned*)(vb_), 16, 0, 0); \
        __builtin_amdgcn_global_load_lds((const unsigned*)(vt_ + voff + 32 * vpitch), (LAS unsigned*)(vb_ + 8192), 16, 0, 0); } while (0)
#define ATT_WAITBAR(n) do { asm volatile("s_waitcnt vmcnt(%0)" :: "n"(n) : "memory"); __builtin_amdgcn_s_barrier(); asm volatile("" ::: "memory"); } while (0)
#pragma unroll
    for (int d = 0; d < 4; ++d)
#pragma unroll
        for (int i = 0; i < 16; ++i) o[d][i] = 0.f;
    float m_used = -INFINITY, l = 0.f;
    const unsigned hs16 = (unsigned)(((hi ^ (r32 >> 1)) & 7) * 16);
    const unsigned kbase = (unsigned)(r32 * C::KROWB);
    const int q4 = (lane & 15) >> 2;
    const unsigned vbase = (unsigned)(C::VOFF + (4 * hi + q4) * 256 + 32 * ((lane >> 4) & 1) + 8 * (lane & 3));
    unsigned xq[4];
#pragma unroll
    for (int db = 0; db < 4; ++db) xq[db] = (unsigned)((64 * db) ^ (64 * q4));
    bf16x8 pbp[4];
#pragma unroll
    for (int k = 0; k < 4; ++k) pbp[k] = (bf16x8){0, 0, 0, 0, 0, 0, 0, 0};
#define ATT_VLOAD1(ks, db) do { \
        const v4i16 lo_ = __builtin_amdgcn_ds_read_tr16_b64_v4i16((LAS v4i16*)(vp_ + (16 * (ks)) * 256 + xq[db])); \
        const v4i16 hh_ = __builtin_amdgcn_ds_read_tr16_b64_v4i16((LAS v4i16*)(vp_ + (16 * (ks) + 8) * 256 + xq[db])); \
        vf[db] = (bf16x8){lo_[0], lo_[1], lo_[2], lo_[3], hh_[0], hh_[1], hh_[2], hh_[3]}; } while (0)
#define ATT_PV_PLAIN(tp) do { const LAS unsigned char* vp_ = lds + vbase + ((tp) & 3) * C::VBYTES; bf16x8 vf[4]; \
        _Pragma("unroll") for (int db = 0; db < 4; ++db) ATT_VLOAD1(0, db); \
        _Pragma("unroll") for (int ks = 0; ks < 4; ++ks) { \
            _Pragma("unroll") for (int db = 0; db < 4; ++db) { o[db] = MFMA32(vf[db], pbp[ks], o[db]); if (ks < 3) ATT_VLOAD1(ks + 1, db); __builtin_amdgcn_sched_barrier(0); } } } while (0)
typedef float f32x2p __attribute__((ext_vector_type(2)));
#define ATT_EXP2P(S, a) do { f32x2p v_ = (f32x2p){S[a], S[(a) + 1]} + nm2; v_.x = __builtin_amdgcn_exp2f(v_.x); v_.y = __builtin_amdgcn_exp2f(v_.y); S[a] = v_.x; S[(a) + 1] = v_.y; ps2 = ps2 + v_; } while (0)
#define ATT_EXP2(k) do { if ((k) < 8) ATT_EXP2P(s0, 2 * (k)); else ATT_EXP2P(s1, 2 * ((k) - 8)); } while (0)
#define ATT_PACK() do { _Pragma("unroll") for (int s = 0; s < 2; ++s) { u32x4 a, b; \
        a.x = pk_bf16(s0[8 * s + 0], s0[8 * s + 1]); a.y = pk_bf16(s0[8 * s + 2], s0[8 * s + 3]); a.z = pk_bf16(s0[8 * s + 4], s0[8 * s + 5]); a.w = pk_bf16(s0[8 * s + 6], s0[8 * s + 7]); \
        b.x = pk_bf16(s1[8 * s + 0], s1[8 * s + 1]); b.y = pk_bf16(s1[8 * s + 2], s1[8 * s + 3]); b.z = pk_bf16(s1[8 * s + 4], s1[8 * s + 5]); b.w = pk_bf16(s1[8 * s + 6], s1[8 * s + 7]); \
        pbp[s] = __builtin_bit_cast(bf16x8, a); pbp[2 + s] = __builtin_bit_cast(bf16x8, b); } } while (0)
    ATT_DMA(0); ATT_DMA(1);
    ATT_WAITBAR(C::NDMA);
    int kst = 0;
    for (int t = 0; t < NT; ++t) {
        const bool more = (t + 2 < NT);
        if (more) ATT_DMA(t + 2);
        if (t <= tl) {
        f32x16 s0, s1;
        {
            const LAS unsigned char* kp0 = lds + kst * C::KBYTES + kbase;
#pragma unroll
            for (int i = 0; i < 16; ++i) { s0[i] = 0.f; s1[i] = 0.f; }
            bf16x8 ka[2], kb[2];
            { const unsigned a0 = hs16; ka[0] = *(const LAS bf16x8*)(kp0 + a0); kb[0] = *(const LAS bf16x8*)(kp0 + 32 * C::KROWB + a0); }
#pragma unroll
            for (int ds = 0; ds < DQK / 16; ++ds) {
                if (ds + 1 < DQK / 16) { const unsigned a1 = (unsigned)(16 * ((2 * (ds + 1)) & ~7)) + ((unsigned)(16 * ((2 * (ds + 1)) & 7)) ^ hs16);
                    ka[(ds + 1) & 1] = *(const LAS bf16x8*)(kp0 + a1); kb[(ds + 1) & 1] = *(const LAS bf16x8*)(kp0 + 32 * C::KROWB + a1); }
                s0 = MFMA32(ka[ds & 1], qf[ds], s0); s1 = MFMA32(kb[ds & 1], qf[ds], s1);
                __builtin_amdgcn_sched_barrier(0);
            }
        }
        const int jb = t - (NT - 4);
        if (jb >= 0) {
            const int qrel = 32 * w + r32 - 64 * jb - 4 * hi;
#pragma unroll
            for (int i = 0; i < 16; ++i) { if ((i & 3) + 8 * (i >> 2) > qrel) s0[i] = -INFINITY; if ((i & 3) + 8 * (i >> 2) + 32 > qrel) s1[i] = -INFINITY; }
        }
        if (t == 0) {
            float rm = fmaxf(s0[0], s1[0]);
#pragma unroll
            for (int i = 1; i < 16; ++i) rm = fmaxf(rm, fmaxf(s0[i], s1[i]));
            m_used = fmaxf(rm, __shfl_xor(rm, 32));
        }
        float ps_tile;
        {
            const LAS unsigned char* vp_ = lds + vbase + ((t ? t - 1 : 0) & 3) * C::VBYTES; bf16x8 vf[4];
            f32x2p ps2 = (f32x2p){0.f, 0.f}; const f32x2p nm2 = (f32x2p){-m_used, -m_used};
#pragma unroll
            for (int db = 0; db < 4; ++db) ATT_VLOAD1(0, db);
#pragma unroll
            for (int ks = 0; ks < 4; ++ks) {
#pragma unroll
                for (int db = 0; db < 4; ++db) { o[db] = MFMA32(vf[db], pbp[ks], o[db]); if (ks < 3) ATT_VLOAD1(ks + 1, db); ATT_EXP2(4 * ks + db); __builtin_amdgcn_sched_barrier(0); } }
            const float ps = ps2.x + ps2.y; l += ps; ps_tile = ps;
            ATT_PACK();
        }
        const float pst = ps_tile + __shfl_xor(ps_tile, 32);
        if (__any(pst > 4096.0f)) {
            const float gr = fmaxf(0.0f, __builtin_log2f(pst)); const float alpha = __builtin_amdgcn_exp2f(-gr); const float mn = m_used + gr;
            l *= alpha; m_used = mn;
#pragma unroll
            for (int d = 0; d < 4; ++d)
#pragma unroll
                for (int i = 0; i < 16; ++i) o[d][i] *= alpha;
#pragma unroll
            for (int k = 0; k < 4; ++k) { u32x4 pw = __builtin_bit_cast(u32x4, pbp[k]);
                pw.x = pk_bf16(bf_lo(pw.x) * alpha, bf_hi(pw.x) * alpha); pw.y = pk_bf16(bf_lo(pw.y) * alpha, bf_hi(pw.y) * alpha);
                pw.z = pk_bf16(bf_lo(pw.z) * alpha, bf_hi(pw.z) * alpha); pw.w = pk_bf16(bf_lo(pw.w) * alpha, bf_hi(pw.w) * alpha);
                pbp[k] = __builtin_bit_cast(bf16x8, pw); }
        }
        if (t == tl) ATT_PV_PLAIN(t);
        }
        if (more) ATT_WAITBAR(C::NDMA); else ATT_WAITBAR(0);
        kst = (kst == 2) ? 0 : kst + 1;
    }
    asm volatile("" ::: "memory"); __builtin_amdgcn_s_barrier(); asm volatile("" ::: "memory");
    l_out = l + __shfl_xor(l, 32);
#undef ATT_DMA
#undef ATT_WAITBAR
#undef ATT_VLOAD1
#undef ATT_PV_PLAIN
#undef ATT_EXP2
#undef ATT_EXP2P
#undef ATT_PACK
}
}

constexpr int NWAVES = 8, NTHREADS = 512;
constexpr int LDS_BYTES = 163840, MISC_OFF = 163584;
struct Args { const void* in[29]; float* out; unsigned char* ws; int ph_lo, ph_hi; };

struct Frame {
    LAS unsigned char* lds; int tid, lane, wave, G, gw, NGW;

};

__device__ __forceinline__ void transpose_item(const float* W, int Kp, int N, bf16_t* WT, int k0, int n0, int dst_row0, int hi_extra, const float* kgain, LAS float* scr, int lane) {
    const float* wp = W + (size_t)(k0 + (lane >> 4)) * N + n0 + 4 * (lane & 15);
    f32x4 v[16];
#pragma unroll
    for (int i = 0; i < 16; ++i) v[i] = *(const f32x4*)(wp + (size_t)(4 * i) * N);
    if (kgain) {
#pragma unroll
        for (int i = 0; i < 16; ++i) v[i] = v[i] * kgain[k0 + 4 * i + (lane >> 4)]; }
#pragma unroll
    for (int i = 0; i < 16; ++i) { LAS float* d = scr + (4 * i + (lane >> 4)) * 65 + 4 * (lane & 15); d[0] = v[i].x; d[1] = v[i].y; d[2] = v[i].z; d[3] = v[i].w; }
    asm volatile("s_waitcnt lgkmcnt(0)" ::: "memory");
    const int c = lane >> 3;
#pragma unroll
    for (int j = 0; j < 8; ++j) { const int n = (lane & 7) + 8 * j; const LAS float* s = scr + (8 * c) * 65 + n;
        u32x4 o; o.x = pk_bf16(s[0 * 65], s[1 * 65]); o.y = pk_bf16(s[2 * 65], s[3 * 65]); o.z = pk_bf16(s[4 * 65], s[5 * 65]); o.w = pk_bf16(s[6 * 65], s[7 * 65]);
        *(u32x4*)(WT + (size_t)(dst_row0 + n + (n >= 32 ? hi_extra : 0)) * Kp + k0 + 8 * c) = o; }
    asm volatile("s_waitcnt lgkmcnt(0)" ::: "memory");
}
__device__ __forceinline__ void transpose_weight(const Frame& F, const float* W, int K, int N, bf16_t* WT, int mode, int Kp = 0, const float* kgain = nullptr) {
    if (Kp == 0) Kp = K;
    LAS float* scr = (LAS float*)(F.lds + F.wave * 16640);
    const int nblk = N / 64, nitems = (K / 64) * nblk;
    for (int it = F.gw; it < nitems; it += F.NGW) {
        const int kb = it / nblk, nb = it % nblk, n0 = 64 * nb; int dst = n0;
        int hx = 0;
        if (mode == 1) {
            if (n0 >= R_END) { const int gc = n0 - R_END, isb = gc >= 2048, c = gc - isb * 2048; dst = 256 * (c >> 7) + 128 * isb + (c & 127); }
            else if (n0 >= R_DV) dst = 4096 + (n0 - R_DV);
            else if (n0 < R_KPE) dst = 5120 + n0;
            else if (n0 < R_DQ) { dst = 256 * 31; hx = 96; }
            else { const int g = (n0 - R_DQ) >> 6; dst = 256 * (23 + (g >> 2)) + 32 * (g & 3); hx = 96; }
        }
        if (mode == 2) { const int isg = n0 >= DFF, c = n0 - isg * DFF; dst = 256 * (c >> 7) + 128 * isg + (c & 127); }
        if (mode == 3) { const int h = n0 / 192, blk = (n0 % 192) >> 6, hb = h >> 2, hq = h & 3;
            dst = blk < 2 ? 256 * (3 * hb + (hq >> 1)) + 32 * (2 * (hq & 1) + blk) : 256 * (3 * hb + 2) + 32 * hq; hx = 96; }
        if (mode == 4) { dst = 256 * (n0 >> 8) + 32 * ((n0 & 255) >> 6); hx = 96; }
        transpose_item(W, Kp, N, WT, 64 * kb, n0, dst, hx, kgain, scr, F.lane);
    }
}
__device__ __forceinline__ void modnorm_rows(const Frame& F, const float* X, const float* g, const float* shift, const float* scale, bf16_t* out) {
    for (int m = F.gw; m < MT; m += F.NGW) {
        const int b = m >> 12;
        const f32x4* xr = (const f32x4*)(X + (size_t)m * DM) + F.lane;
        f32x4 v[8]; float s = 0.f;
#pragma unroll
        for (int j = 0; j < 8; ++j) { v[j] = xr[64 * j]; s += (v[j].x * v[j].x + v[j].y * v[j].y) + (v[j].z * v[j].z + v[j].w * v[j].w); }
        const float rs = 1.0f / sqrtf(wave_sum(s) * (1.0f / DM) + EPS);
        u32x2* o8 = (u32x2*)(out + (size_t)m * DM) + F.lane;
#pragma unroll
        for (int j = 0; j < 8; ++j) { const int col = 256 * j + 4 * F.lane;
            const f32x4 gg = *(const f32x4*)(g + col), sc = *(const f32x4*)(scale + (size_t)b * 6 * DM + col), sh = *(const f32x4*)(shift + (size_t)b * 6 * DM + col);
            const f32x4 y = v[j] * rs * gg * (sc + 1.0f) + sh;
            u32x2 wv; wv.x = pk_bf16(y.x, y.y); wv.y = pk_bf16(y.z, y.w); o8[64 * j] = wv; }
    }
}
__device__ __forceinline__ void modnorm_rows_bf16(const Frame& F, const bf16_t* X, const float* g, const float* shift, const float* scale, bf16_t* out) {
    for (int m = F.gw; m < MT; m += F.NGW) {
        const int b = m >> 12;
        const u32x4* xr = (const u32x4*)(X + (size_t)m * DM) + F.lane;
        float v[4][8]; float s = 0.f;
#pragma unroll
        for (int j = 0; j < 4; ++j) { const u32x4 raw = xr[64 * j]; unpack8(raw, v[j]);
#pragma unroll
            for (int e = 0; e < 8; ++e) s += v[j][e] * v[j][e]; }
        const float rs = 1.0f / sqrtf(wave_sum(s) * (1.0f / DM) + EPS);
        u32x4* o16 = (u32x4*)(out + (size_t)m * DM) + F.lane;
#pragma unroll
        for (int j = 0; j < 4; ++j) { const int col = 512 * j + 8 * F.lane; float y[8];
#pragma unroll
            for (int hh = 0; hh < 2; ++hh) { const f32x4 gg = *(const f32x4*)(g + col + 4 * hh), sc = *(const f32x4*)(scale + (size_t)b * 6 * DM + col + 4 * hh), sh = *(const f32x4*)(shift + (size_t)b * 6 * DM + col + 4 * hh);
#pragma unroll
                for (int e = 0; e < 4; ++e) y[4 * hh + e] = v[j][4 * hh + e] * rs * gg[e] * (sc[e] + 1.0f) + sh[e]; }
            o16[64 * j] = pack8(y); }
    }
}
__device__ __forceinline__ void vtranspose(const Frame& F, const bf16_t* src, int pitch, int col0, int hstride, bf16_t* dst) {
    LAS unsigned char* T = F.lds + F.wave * 18432;
    const int lane = F.lane;
    for (int it = F.gw; it < 2048; it += F.NGW) {
        const int b = it >> 9, h = (it >> 6) & 7, sc = it & 63;
        const bf16_t* sp = src + (size_t)(b * SEQ + 64 * sc) * pitch + col0 + h * hstride;
        u32x4 rawv[16];
#pragma unroll
        for (int i = 0; i < 16; ++i) rawv[i] = *(const u32x4*)(sp + (size_t)(4 * i + (lane >> 4)) * pitch + 8 * (lane & 15));
#pragma unroll
        for (int i = 0; i < 16; ++i) { const int tok = 4 * i + (lane >> 4), ch = lane & 15;
            const u32x4 raw = rawv[i];
            const int ptok = (tok & ~12) | ((tok & 4) << 1) | ((tok & 8) >> 1);
            LAS unsigned short* tp = (LAS unsigned short*)(T + (8 * ch) * 144 + ptok * 2);
            tp[0 * 72] = (unsigned short)(raw.x & 0xffff); tp[1 * 72] = (unsigned short)(raw.x >> 16); tp[2 * 72] = (unsigned short)(raw.y & 0xffff); tp[3 * 72] = (unsigned short)(raw.y >> 16);
            tp[4 * 72] = (unsigned short)(raw.z & 0xffff); tp[5 * 72] = (unsigned short)(raw.z >> 16); tp[6 * 72] = (unsigned short)(raw.w & 0xffff); tp[7 * 72] = (unsigned short)(raw.w >> 16); }
        asm volatile("s_waitcnt lgkmcnt(0)" ::: "memory");
        bf16_t* dp = dst + (size_t)((b * 8 + h) * 128) * SEQ + 64 * sc;
#pragma unroll 4
        for (int i = 0; i < 16; ++i) { const int dv = 8 * i + (lane >> 3), c8 = lane & 7;
            const u32x4 v = *(const LAS u32x4*)(T + dv * 144 + 16 * c8);
            *(u32x4*)(dp + (size_t)dv * SEQ + 8 * c8) = v; }
        asm volatile("s_waitcnt lgkmcnt(0)" ::: "memory");
    }
}


#define XB_TMO      128
#define XB_XCNT(j)  (256  + 64 * (j))
#define XB_XSUB(j)  (1280 + 64 * (j))
#define XB_XGEN(j)  (2304 + 64 * (j))
#define XB_TOP      3328
#define XB_TOPGEN   3392
#define XCD_BAR_WORDS 3456
#define XB_SPIN_CAP (1u << 18)
__device__ __forceinline__ unsigned xb_ld(unsigned* p)              { return __hip_atomic_load(p, __ATOMIC_RELAXED, __HIP_MEMORY_SCOPE_AGENT); }
__device__ __forceinline__ unsigned xb_add(unsigned* p, unsigned v) { return __hip_atomic_fetch_add(p, v, __ATOMIC_RELAXED, __HIP_MEMORY_SCOPE_AGENT); }
__device__ __forceinline__ unsigned xb_xcc_id() { return (unsigned)__builtin_amdgcn_s_getreg((3 << 11) | 20) & 0xFu; }
#define XB_SPIN(cond, bar) do { unsigned _sp = 0; while (cond) { __builtin_amdgcn_s_sleep(1); \
    if ((++_sp & 255u) == 0u) { if (xb_ld(&(bar)[XB_TMO])) break; if (_sp > XB_SPIN_CAP) { atomicAdd(&(bar)[XB_TMO], 1u); break; } } } } while (0)
struct XcdBarrier { unsigned* bar; unsigned x; volatile LAS unsigned* st; };
__device__ __forceinline__ XcdBarrier xcd_barrier_post(unsigned* bar, volatile LAS unsigned* st) {
    XcdBarrier b; b.bar = bar; b.x = xb_xcc_id(); b.st = st;
    if (threadIdx.x == 0) (void)xb_add(&bar[XB_XCNT(b.x)], 1u);
    return b;
}
__device__ __forceinline__ void xcd_barrier_complete(unsigned* bar, unsigned x, unsigned& nloc, unsigned& nx) {
    const unsigned G = gridDim.x * gridDim.y * gridDim.z;
    unsigned sum, cnt, mine, sp = 0u;
    for (;;) {
        sum = 0u; cnt = 0u; mine = 0u;
#pragma unroll
        for (unsigned j = 0; j < 16; ++j) { const unsigned c = xb_ld(&bar[XB_XCNT(j)]); sum += c; cnt += (c > 0u) ? 1u : 0u; mine = (j == x) ? c : mine; }
        if (sum == G) break;
        __builtin_amdgcn_s_sleep(1);
        if ((++sp & 255u) == 0u) { if (xb_ld(&bar[XB_TMO])) break; if (sp > XB_SPIN_CAP) { atomicAdd(&bar[XB_TMO], 1u); break; } }
    }
    nloc = mine > 0u ? mine : 1u; nx = cnt > 0u ? cnt : 1u;
}
__device__ __forceinline__ void xcd_barrier(const XcdBarrier& b) {
    asm volatile("s_waitcnt vmcnt(0)" ::: "memory");
    __syncthreads();
    if (threadIdx.x == 0) {
        unsigned* bar = b.bar;
        __builtin_amdgcn_s_waitcnt(0);
        unsigned nloc = b.st[0], nx = b.st[1];
        if (nloc == 0u) { xcd_barrier_complete(bar, b.x, nloc, nx); b.st[0] = nloc; b.st[1] = nx; }
        const unsigned old = xb_add(&bar[XB_XSUB(b.x)], 1u);
        const unsigned gen = old / nloc;
        if (old + 1u == (gen + 1u) * nloc) {
            __builtin_amdgcn_fence(__ATOMIC_RELEASE, "agent");
            asm volatile("s_waitcnt vmcnt(0)" ::: "memory");
            const unsigned og = xb_add(&bar[XB_TOP], 1u);
            const unsigned tg = og / nx;
            if (og + 1u == (tg + 1u) * nx) xb_add(&bar[XB_TOPGEN], 1u);
            else XB_SPIN(xb_ld(&bar[XB_TOPGEN]) == tg, bar);
            __builtin_amdgcn_fence(__ATOMIC_ACQUIRE, "agent");
            xb_add(&bar[XB_XGEN(b.x)], 1u);
            asm volatile("s_waitcnt vmcnt(0)" ::: "memory");
        } else {
            XB_SPIN(xb_ld(&bar[XB_XGEN(b.x)]) == gen, bar);
            __builtin_amdgcn_fence(__ATOMIC_ACQUIRE, "agent");
            asm volatile("s_waitcnt vmcnt(0)" ::: "memory");
        }
    }
    __syncthreads();
}
constexpr int CW_BAR = 4096;
constexpr size_t CTL_ZERO_BYTES = 65536;
#define P_x ((const float*)args.in[0])
#define P_cvec ((const float*)args.in[1])
#define P_pos ((const int*)args.in[2])
#define P_w_ada ((const float*)args.in[3])
#define P_b_ada ((const float*)args.in[4])
#define P_g_norm1 ((const float*)args.in[5])
#define P_w_in ((const float*)args.in[6])
#define P_b_gate ((const float*)args.in[7])
#define P_g_q_lat ((const float*)args.in[8])
#define P_w_q_up ((const float*)args.in[9])
#define P_g_kv_lat ((const float*)args.in[10])
#define P_w_kv_up ((const float*)args.in[11])
#define P_g_q_mla ((const float*)args.in[12])
#define P_g_k_mla ((const float*)args.in[13])
#define P_w_o_mla ((const float*)args.in[14])
#define P_g_q_diff ((const float*)args.in[15])
#define P_g_k_diff ((const float*)args.in[16])
#define P_lam_q1 ((const float*)args.in[17])
#define P_lam_k1 ((const float*)args.in[18])
#define P_lam_q2 ((const float*)args.in[19])
#define P_lam_k2 ((const float*)args.in[20])
#define P_g_sub ((const float*)args.in[21])
#define P_w_o_diff ((const float*)args.in[22])
#define P_w_out ((const float*)args.in[23])
#define P_g_norm2 ((const float*)args.in[24])
#define P_w_up ((const float*)args.in[25])
#define P_conv_w ((const float*)args.in[26])
#define P_conv_b ((const float*)args.in[27])
#define P_w_down ((const float*)args.in[28])
#define P_out (args.out)
#define P_ctl ((unsigned*)(args.ws + WS_CTL))
#define P_mod ((float*)(args.ws + WS_MOD))
#define P_part ((float*)(args.ws + WS_PART))
#define P_KPE ((bf16_t*)(args.ws + WS_KPE))
#define P_WB1 ((bf16_t*)(args.ws + WS_WB1))
#define P_WQ ((bf16_t*)(args.ws + WS_WQ))
#define P_WKV ((bf16_t*)(args.ws + WS_WKV))
#define P_WOM ((bf16_t*)(args.ws + WS_WOM))
#define P_WOUT ((bf16_t*)(args.ws + WS_WOUT))
#define P_Hb ((bf16_t*)(args.ws + WS_H))
#define P_DQ ((bf16_t*)(args.ws + WS_DQ))
#define P_DK ((bf16_t*)(args.ws + WS_DK))
#define P_MIX ((bf16_t*)(args.ws + WS_MIX))
#define P_Gb ((bf16_t*)(args.ws + WS_G))
#define P_WUP ((bf16_t*)(args.ws + WS_WUP))
#define P_WDN ((bf16_t*)(args.ws + WS_WDN))
#define P_O2 ((bf16_t*)(args.ws + WS_O2))
#define P_ACT ((bf16_t*)(args.ws + WS_ACT))
#define P_SIDE ((float*)(args.ws + WS_SIDE))
#define P_X1B ((bf16_t*)(args.ws + WS_X1B))
#define P_DV ((bf16_t*)(args.ws + WS_DV))
#define P_QM ((bf16_t*)(args.ws + WS_QM))
#define P_KN ((bf16_t*)(args.ws + WS_KN))
#define P_RAWQ ((bf16_t*)(args.ws + WS_RAWQ))
#define P_RAWKV ((bf16_t*)(args.ws + WS_RAWKV))
#define P_SSQ ((float*)(args.ws + WS_SSQ))
#define P_VM ((bf16_t*)(args.ws + WS_VM))
__global__ void __launch_bounds__(NTHREADS, 2) fwd_kernel(Args args) {
    extern __shared__ __attribute__((aligned(16))) unsigned char lds_raw[];
    cg::grid_group grid = cg::this_grid();
    Frame F;
    F.lds = (LAS unsigned char*)lds_raw; F.tid = threadIdx.x; F.lane = F.tid & 63; F.wave = __builtin_amdgcn_readfirstlane(F.tid >> 6);
    F.G = gridDim.x; F.gw = blockIdx.x * NWAVES + F.wave; F.NGW = F.G * NWAVES;
    volatile LAS int* misc = (volatile LAS int*)(F.lds + MISC_OFF);
    if (F.tid < 32) misc[F.tid] = 0;
    __syncthreads();
    const XcdBarrier bar = xcd_barrier_post(P_ctl + CW_BAR, (volatile LAS unsigned*)(misc + 8));
    if (args.ph_lo < 0) grid.sync();

    const int lo = args.ph_lo, hi_ = args.ph_hi;
#ifndef PHASE_MASK
#define PHASE_MASK 0x7fff
#endif
#define IN(k) (((PHASE_MASK >> (k)) & 1) && lo <= (k) && (k) < hi_)
#define SEAM(k) do { if (IN(k) && IN((k) + 1)) xcd_barrier(bar); } while (0)
#ifndef REP_MASK
#define REP_MASK 0
#endif
#define REPS(k) ((((REP_MASK) >> (k)) & 1) ? 2 : 1)
#define PHASE(k) if (IN(k)) for (int rep = 0; rep < REPS(k); ++rep, (rep < REPS(k) ? xcd_barrier(bar) : (void)0))

    PHASE(0) {
        for (int it = blockIdx.x; it < 192; it += F.G) {
            const int e = 64 * it + F.lane, d0 = 256 * F.wave;
            float a0 = 0.f, a1 = 0.f, a2 = 0.f, a3 = 0.f;
#pragma unroll 1
            for (int dq = 0; dq < 4; ++dq) {
                float sl[4];
#pragma unroll
                for (int b = 0; b < 4; ++b) { const float cv = P_cvec[b * DM + d0 + 64 * dq + F.lane]; sl[b] = cv * sigmoidf_fast(cv); }
#pragma unroll 16
                for (int dd = 0; dd < 64; ++dd) {
                    const float wv = P_w_ada[(size_t)(d0 + 64 * dq + dd) * (6 * DM) + e];
                    a0 += wv * __shfl(sl[0], dd); a1 += wv * __shfl(sl[1], dd); a2 += wv * __shfl(sl[2], dd); a3 += wv * __shfl(sl[3], dd);
                }
            }
            LAS float* red = (LAS float*)(F.lds + 133120);
            __syncthreads();
            red[(F.wave * 4 + 0) * 64 + F.lane] = a0; red[(F.wave * 4 + 1) * 64 + F.lane] = a1; red[(F.wave * 4 + 2) * 64 + F.lane] = a2; red[(F.wave * 4 + 3) * 64 + F.lane] = a3;
            __syncthreads();
            if (F.wave < 4) { float sacc = P_b_ada[e];
#pragma unroll
                for (int w8 = 0; w8 < 8; ++w8) sacc += red[(w8 * 4 + F.wave) * 64 + F.lane];
                P_mod[F.wave * (6 * DM) + e] = sacc; }
        }
        transpose_weight(F, P_w_in, DM, 8000, P_WB1, 1);
        transpose_weight(F, P_w_q_up, 512, 1536, P_WQ, 3, 0, P_g_q_lat);
        transpose_weight(F, P_w_kv_up, 256, 2048, P_WKV, 4, 0, P_g_kv_lat);
        transpose_weight(F, P_w_o_mla, 1024, DM, P_WOM, 0, 2048);
        transpose_weight(F, P_w_o_diff, 1024, DM, P_WOM + 1024, 0, 2048);
        transpose_weight(F, P_w_out, DM, DM, P_WOUT, 0);
    }
    SEAM(0);
    PHASE(2) modnorm_rows(F, P_x, P_g_norm1, P_mod + 0 * DM, P_mod + 1 * DM, P_Hb);
    SEAM(2);
    PHASE(3) {
        pg8::Gemm g{P_Hb, P_WB1, MT, 8192, DM, DM, 0}; pg8::StaticOrder S; S.init(MT, 8192, F.G, (int)blockIdx.x);
        pg8::EpiProj E{P_Gb, P_b_gate, P_g_q_diff, P_g_k_diff, P_g_k_mla, P_pos};
        pg8::gemm_phase(F.lds, g, S, E);
    }
    SEAM(3);
    PHASE(5) {
        LAS float* xch = (LAS float*)(F.lds + 133120);
        { pg8::Gemm g{P_RAWQ, P_WQ, MT, 1536, 512, 512, 0}; pg8::StaticOrder S; S.init(MT, 1536, F.G, (int)blockIdx.x); pg8::EpiQ E{P_QM, P_SSQ, P_g_q_mla, P_pos, xch}; pg8::gemm_phase(F.lds, g, S, E); }
        { pg8::Gemm g{P_RAWKV, P_WKV, MT, 2048, 256, 256, 0}; pg8::StaticOrder S; S.init(MT, 2048, F.G, (int)blockIdx.x); pg8::EpiKV E{P_KN, P_VM, P_SSQ, P_g_k_mla, xch}; pg8::gemm_phase(F.lds, g, S, E); }
    }
    SEAM(5);
    PHASE(7) {
        float lam;
        { const float a = wave_sum(P_lam_q1[F.lane] * P_lam_k1[F.lane]), b = wave_sum(P_lam_q2[F.lane] * P_lam_k2[F.lane]); lam = expf(a) - expf(b) + LAMBDA_INIT; }
        const int lane = F.lane, r32 = lane & 31, hi = lane >> 5, w = F.wave;
        for (;;) {
            if (F.tid == 0) misc[0] = (int)__hip_atomic_fetch_add(P_ctl, 1u, __ATOMIC_RELAXED, __HIP_MEMORY_SCOPE_AGENT);
            __syncthreads();
            const int uidx = misc[0] - rep * (1024 + F.G);
            __syncthreads();
            if (uidx >= 1024) break;
            const int qb = 15 - (uidx >> 6), within = uidx & 63, kind = within >> 5, bh = within & 31, b = bh >> 3, h = bh & 7;
            const int q0 = 256 * qb; const size_t row0 = (size_t)b * SEQ; const size_t mrow = row0 + q0 + 32 * w + r32;
            f32x16 o[4]; float l;
            LAS unsigned char* const ostg = F.lds + w * 8704;
#define O_FLUSH(colbase) do { bf16_t* ob_ = P_O2 + (row0 + q0 + 32 * w) * DM + (colbase); \
        _Pragma("unroll") for (int i_ = 0; i_ < 8; ++i_) { const int rw_ = 4 * i_ + (lane >> 4); const u32x4 v_ = *(const LAS u32x4*)(ostg + rw_ * 272 + 16 * (lane & 15)); \
            *(u32x4*)(ob_ + (size_t)rw_ * DM + 8 * (lane & 15)) = v_; } } while (0)
            if (kind == 1) {
                att::attn_tiles<192>(P_QM + row0 * 1536 + 192 * h, 1536, P_KN + row0 * 1024 + 128 * h, 1024, P_KPE + row0 * 64, P_VM + row0 * 1024 + 128 * h, 1024, q0, F.lds, o, l);
                const float inv = 1.0f / l;
#pragma unroll
                for (int db = 0; db < 4; ++db)
#pragma unroll
                    for (int g = 0; g < 4; ++g) { u32x2 wv; wv.x = pk_bf16(o[db][4 * g] * inv, o[db][4 * g + 1] * inv); wv.y = pk_bf16(o[db][4 * g + 2] * inv, o[db][4 * g + 3] * inv);
                        *(LAS u32x2*)(ostg + r32 * 272 + (32 * db + 8 * g + 4 * hi) * 2) = wv; }
                O_FLUSH(128 * h);
            } else {
                const bf16_t* Vt = P_DV + row0 * 1024 + 128 * h;
                att::attn_tiles<64>(P_DQ + row0 * 1024 + 128 * h, 1024, P_DK + row0 * 1024 + 128 * h, 1024, nullptr, Vt, 1024, q0, F.lds, o, l);
                LAS unsigned* stash = (LAS unsigned*)(F.lds + att::Cfg<64>::TOTAL) + F.tid;
                { const float inv = 1.0f / l;
#pragma unroll
                  for (int db = 0; db < 4; ++db)
#pragma unroll
                      for (int g = 0; g < 4; ++g) { stash[(db * 8 + g * 2) * 512] = pk_bf16(o[db][4 * g] * inv, o[db][4 * g + 1] * inv); stash[(db * 8 + g * 2 + 1) * 512] = pk_bf16(o[db][4 * g + 2] * inv, o[db][4 * g + 3] * inv); } }
                att::attn_tiles<64>(P_DQ + row0 * 1024 + 128 * h + 64, 1024, P_DK + row0 * 1024 + 128 * h + 64, 1024, nullptr, Vt, 1024, q0, F.lds, o, l);
                const float inv2 = lam / l; float ss = 0.f;
#pragma unroll
                for (int db = 0; db < 4; ++db)
#pragma unroll
                    for (int g = 0; g < 4; ++g) {
                        const unsigned sx = stash[(db * 8 + g * 2) * 512], sy = stash[(db * 8 + g * 2 + 1) * 512];
                        const float d0 = bf_lo(sx) - inv2 * o[db][4 * g], d1 = bf_hi(sx) - inv2 * o[db][4 * g + 1];
                        const float d2 = bf_lo(sy) - inv2 * o[db][4 * g + 2], d3 = bf_hi(sy) - inv2 * o[db][4 * g + 3];
                        o[db][4 * g] = d0; o[db][4 * g + 1] = d1; o[db][4 * g + 2] = d2; o[db][4 * g + 3] = d3; ss += (d0 * d0 + d1 * d1) + (d2 * d2 + d3 * d3); }
                ss += __shfl_xor(ss, 32);
                const float rs = (1.0f - LAMBDA_INIT) / sqrtf(ss * (1.0f / 128.0f) + EPS);
#pragma unroll
                for (int db = 0; db < 4; ++db)
#pragma unroll
                    for (int g = 0; g < 4; ++g) { const int dv = 32 * db + 8 * g + 4 * hi; const f32x4 gs = *(const f32x4*)(P_g_sub + dv);
                        u32x2 wv; wv.x = pk_bf16(o[db][4 * g] * rs * gs.x, o[db][4 * g + 1] * rs * gs.y); wv.y = pk_bf16(o[db][4 * g + 2] * rs * gs.z, o[db][4 * g + 3] * rs * gs.w);
                        *(LAS u32x2*)(ostg + r32 * 272 + dv * 2) = wv; }
                O_FLUSH(1024 + 128 * h);
            }
        }
    }
#undef O_FLUSH
    SEAM(7);
    PHASE(8) { pg8::Gemm g{P_O2, P_WOM, MT, DM, 1024, 2048, 2048}; pg8::StaticOrder S; S.init(MT, DM, F.G, (int)blockIdx.x); pg8::EpiGate<false> E{P_MIX, nullptr, P_Gb + (size_t)MT * 2048, 0}; pg8::RatioHook Hk{P_Gb};
        pg8::gemm_phase<pg8::EpiGate<false>, true, pg8::RatioHook>(F.lds, g, S, E, Hk); }
    SEAM(8);
    PHASE(10) { pg8::Gemm g{P_MIX, P_WOUT, MT, DM, DM, DM, 0}; pg8::StaticOrder S; S.init(MT, DM, F.G, (int)blockIdx.x); pg8::EpiRes1 E{P_x, P_X1B, P_mod + 2 * DM}; pg8::gemm_phase(F.lds, g, S, E); }
    SEAM(10);
    PHASE(11) {
        modnorm_rows_bf16(F, P_X1B, P_g_norm2, P_mod + 3 * DM, P_mod + 4 * DM, P_Hb);
        transpose_weight(F, P_w_up, DM, NUP, P_WUP, 2);
        transpose_weight(F, P_w_down, DFF, DM, P_WDN, 0);
    }
    SEAM(11);
    PHASE(12) { pg8::Gemm g{P_Hb, P_WUP, MT, NUP, DM, DM, 0}; pg8::StaticOrder S; S.init(MT, NUP, F.G, (int)blockIdx.x); pg8::EpiConv E{P_ACT, P_SIDE, P_conv_w, P_conv_b}; pg8::gemm_phase(F.lds, g, S, E); }
    SEAM(12);
    PHASE(13) {
        for (int i = blockIdx.x * NTHREADS + F.tid; i < 256 * 2 * (DFF / 4); i += F.G * NTHREADS) {
            const int c = (i % (DFF / 4)) * 4, j = (i / (DFF / 4)) & 1, seg = i / (2 * (DFF / 4));
            const bool hasprev = (seg & 63) != 0;
            const float* sp = P_SIDE + (size_t)seg * 4 * NUP; const float* pp = P_SIDE + (size_t)(seg - 1) * 4 * NUP;
            const f32x4 z = (f32x4){0.f, 0.f, 0.f, 0.f};
            f32x4 a;
            f32x4 y[2];
#pragma unroll
            for (int hlf = 0; hlf < 2; ++hlf) {
                const int cc = c + hlf * DFF;
                const f32x4 ut = *(const f32x4*)(sp + (size_t)j * NUP + cc);
                const f32x4 u1 = j ? *(const f32x4*)(sp + cc) : (hasprev ? *(const f32x4*)(pp + (size_t)3 * NUP + cc) : z);
                const f32x4 u2 = hasprev ? *(const f32x4*)(pp + (size_t)(j ? 3 : 2) * NUP + cc) : z;
                const f32x4 w0 = *(const f32x4*)(P_conv_w + cc), w1 = *(const f32x4*)(P_conv_w + NUP + cc), w2 = *(const f32x4*)(P_conv_w + 2 * NUP + cc), bb = *(const f32x4*)(P_conv_b + cc);
                y[hlf] = bb + w2 * ut + w1 * u1 + w0 * u2;
            }
#pragma unroll
            for (int q = 0; q < 4; ++q) a[q] = y[0][q] * y[1][q] * sigmoidf_fast(y[1][q]);
            u32x2 wv; wv.x = pk_bf16(a[0], a[1]); wv.y = pk_bf16(a[2], a[3]);
            *(u32x2*)(P_ACT + ((size_t)seg * 64 + j) * DFF + c) = wv;
        }
    }
    SEAM(13);
    PHASE(14) { pg8::Gemm g{P_ACT, P_WDN, MT, DM, DFF, DFF, 0}; pg8::StaticOrder S; S.init(MT, DM, F.G, (int)blockIdx.x); pg8::EpiRes2 E{P_X1B, P_out, P_mod + 5 * DM}; pg8::gemm_phase(F.lds, g, S, E); }
#undef IN
#undef SEAM
}

#undef P_x
#undef P_cvec
#undef P_pos
#undef P_w_ada
#undef P_b_ada
#undef P_g_norm1
#undef P_w_in
#undef P_b_gate
#undef P_g_q_lat
#undef P_w_q_up
#undef P_g_kv_lat
#undef P_w_kv_up
#undef P_g_q_mla
#undef P_g_k_mla
#undef P_w_o_mla
#undef P_g_q_diff
#undef P_g_k_diff
#undef P_lam_q1
#undef P_lam_k1
#undef P_lam_q2
#undef P_lam_k2
#undef P_g_sub
#undef P_w_o_diff
#undef P_w_out
#undef P_g_norm2
#undef P_w_up
#undef P_conv_w
#undef P_conv_b
#undef P_w_down
#undef P_out
#undef P_ctl
#undef P_mod
#undef P_part
#undef P_KPE
#undef P_WB1
#undef P_WQ
#undef P_WKV
#undef P_WOM
#undef P_WOUT
#undef P_Hb
#undef P_DQ
#undef P_DK
#undef P_MIX
#undef P_Gb
#undef P_WUP
#undef P_WDN
#undef P_O2
#undef P_ACT
#undef P_SIDE
#undef P_X1B
#undef P_DV
#undef P_QM
#undef P_KN
#undef P_RAWQ
#undef P_RAWKV
#undef P_SSQ
#undef P_VM
#ifndef N_LAUNCHES
#define N_LAUNCHES 1
#endif
constexpr int N_PHASES = 15;

extern "C" void kernel_launch(void* const* d_in, const int* in_sizes, int n_in, void* d_out, int out_size, void* d_ws, size_t ws_size, hipStream_t stream) {
    static int grid = 0;
    if (grid == 0) {
        if (n_in != 29 || in_sizes[0] != MT * DM || out_size != MT * DM || ws_size < WS_END) {
            fprintf(stderr, "kernel_launch: unexpected shapes: n_in %d in0 %d out %d ws %zu (need %zu)\n", n_in, n_in > 0 ? in_sizes[0] : -1, out_size, ws_size, (size_t)WS_END); grid = -1; return; }
        int dev = 0, cus = 0, per_cu = 0;
        (void)hipGetDevice(&dev); (void)hipDeviceGetAttribute(&cus, hipDeviceAttributeMultiprocessorCount, dev);
        if (hipFuncSetAttribute((const void*)fwd_kernel, hipFuncAttributeMaxDynamicSharedMemorySize, LDS_BYTES) != hipSuccess) { fprintf(stderr, "kernel_launch: hipFuncSetAttribute failed\n"); grid = -1; return; }
        if (hipOccupancyMaxActiveBlocksPerMultiprocessor(&per_cu, (const void*)fwd_kernel, NTHREADS, LDS_BYTES) != hipSuccess || per_cu < 1) { fprintf(stderr, "kernel_launch: occupancy query says %d blocks per CU\n", per_cu); per_cu = 1; }
        (void)hipGetLastError();
        grid = cus * 1;
        if (grid <= 0) grid = 256;
    }
    if (grid < 0) return;
    if (hipMemsetAsync((char*)d_ws + WS_CTL, 0, CTL_ZERO_BYTES, stream) != hipSuccess) { fprintf(stderr, "kernel_launch: hipMemsetAsync failed\n"); return; }
    Args a{};
    for (int i = 0; i < 29; ++i) a.in[i] = d_in[i];
    a.out = (float*)d_out; a.ws = (unsigned char*)d_ws;
#if N_LAUNCHES == 1
    a.ph_lo = 0; a.ph_hi = N_PHASES;
    void* kargs[] = {&a};
    hipError_t e = hipLaunchCooperativeKernel((const void*)fwd_kernel, dim3(grid), dim3(NTHREADS), kargs, LDS_BYTES, stream);
    if (e != hipSuccess) fprintf(stderr, "kernel_launch: cooperative launch failed: %s (grid %d)\n", hipGetErrorString(e), grid);
#else
    for (int p = 0; p < N_PHASES; ++p) {
        a.ph_lo = p; a.ph_hi = p + 1;
        void* kargs[] = {&a};
        hipError_t e = hipLaunchCooperativeKernel((const void*)fwd_kernel, dim3(grid), dim3(NTHREADS), kargs, LDS_BYTES, stream);
        if (e != hipSuccess) { fprintf(stderr, "kernel_launch: launch %d failed: %s\n", p, hipGetErrorString(e)); break; }
    }
#endif
}
```

```cpp
#include <hip/hip_runtime.h>
#include <hip/hip_cooperative_groups.h>
#include <cstdio>
#include <cstdint>
namespace cg = cooperative_groups;

#define LAS __attribute__((address_space(3)))
typedef unsigned short bf16_t;
typedef short bf16x8 __attribute__((ext_vector_type(8)));
typedef float f32x4 __attribute__((ext_vector_type(4)));
typedef float f32x16 __attribute__((ext_vector_type(16)));
typedef unsigned u32x4 __attribute__((ext_vector_type(4)));
typedef unsigned u32x2 __attribute__((ext_vector_type(2)));

constexpr int NB = 4, SEQ = 4096, DM = 2048, MT = NB * SEQ;
constexpr int DFF = 5632, NUP = 2 * DFF;
constexpr int R_KVL = 512, R_KPE = 768, R_DQ = 832, R_DK = 1856, R_DV = 2880, R_END = 3904;
constexpr int RP = 4096;
constexpr float EPS = 1e-6f;
constexpr float LOG2E = 1.4426950408889634f;
constexpr float QS_MLA = 0.07216878364870322f * LOG2E;
constexpr float QS_DIFF = 0.125f * LOG2E;
constexpr float LAMBDA_INIT = 0.2f;

constexpr size_t MiB = 1u << 20;
constexpr size_t WS_CTL = 0, WS_MOD = 256 * 1024, WS_PART = 1 * MiB, WS_KPE = 8 * MiB;
constexpr size_t WS_WB1 = 10 * MiB;
constexpr size_t WS_WQ = 42 * MiB, WS_WKV = 43 * MiB + 512 * 1024;
constexpr size_t WS_WOM = 45 * MiB, WS_WOD = 49 * MiB, WS_WOUT = 53 * MiB;
constexpr size_t WS_H = 61 * MiB, WS_O2 = 61 * MiB;
constexpr size_t WS_G = 125 * MiB, WS_WUP = 125 * MiB, WS_WDN = 169 * MiB;
constexpr size_t WS_DQ = 253 * MiB, WS_DK = 285 * MiB, WS_RAWQ = 317 * MiB, WS_RAWKV = 333 * MiB, WS_SSQ = 341 * MiB, WS_VM = 349 * MiB, WS_MIX = 253 * MiB, WS_ACT = 253 * MiB, WS_SIDE = 8 * MiB, WS_X1B = 429 * MiB;
constexpr size_t WS_DV = 381 * MiB, WS_QM = 413 * MiB, WS_KN = 461 * MiB;
constexpr size_t WS_END = 512 * MiB;

__device__ __forceinline__ unsigned pk_bf16(float lo, float hi) {
    typedef float f2 __attribute__((ext_vector_type(2))); typedef __bf16 b2 __attribute__((ext_vector_type(2)));
    f2 v = {lo, hi}; b2 b = __builtin_convertvector(v, b2); return __builtin_bit_cast(unsigned, b);
}
__device__ __forceinline__ float bf_lo(unsigned u) { return __uint_as_float(u << 16); }
__device__ __forceinline__ float bf_hi(unsigned u) { return __uint_as_float(u & 0xffff0000u); }
__device__ __forceinline__ void unpack8(const u32x4 r, float (&v)[8]) {
    v[0] = bf_lo(r.x); v[1] = bf_hi(r.x); v[2] = bf_lo(r.y); v[3] = bf_hi(r.y); v[4] = bf_lo(r.z); v[5] = bf_hi(r.z); v[6] = bf_lo(r.w); v[7] = bf_hi(r.w);
}
__device__ __forceinline__ u32x4 pack8(const float (&v)[8]) { u32x4 r; r.x = pk_bf16(v[0], v[1]); r.y = pk_bf16(v[2], v[3]); r.z = pk_bf16(v[4], v[5]); r.w = pk_bf16(v[6], v[7]); return r; }
__device__ __forceinline__ float sigmoidf_fast(float x) { return __builtin_amdgcn_rcpf(1.0f + __builtin_amdgcn_exp2f(-x * LOG2E)); }
__device__ __forceinline__ float wave_sum(float v) {
#pragma unroll
    for (int o = 1; o < 64; o <<= 1) v += __shfl_xor(v, o);
    return v;
}
__device__ __forceinline__ void rope_cs(int pos, int i, float& cs, float& sn) {
    const float inv_freq = __builtin_amdgcn_exp2f(-(float)i * (13.287712379549449f / 32.0f));
    const float ang = (float)pos * inv_freq;
    const float n = rintf(ang * 0.15915494309189535f);
    float r = fmaf(-n, 6.2831854820251465f, ang);
    r = fmaf(-n, -1.7484555e-7f, r);
    const float rev = r * 0.15915494309189535f;
    cs = __builtin_amdgcn_cosf(rev); sn = __builtin_amdgcn_sinf(rev);
}

__device__ __forceinline__ float rope_invf(int i) { return __builtin_amdgcn_exp2f(-(float)i * (13.287712379549449f / 32.0f)); }
__device__ __forceinline__ void rope_cs2(float posf, float invf, float& cs, float& sn) {
    const float ang = posf * invf;
    const float n = rintf(ang * 0.15915494309189535f);
    float r = fmaf(-n, 6.2831854820251465f, ang);
    r = fmaf(-n, -1.7484555e-7f, r);
    const float rev = r * 0.15915494309189535f;
    cs = __builtin_amdgcn_cosf(rev); sn = __builtin_amdgcn_sinf(rev);
}
#define EPI_LDS_BAR() do { asm volatile("s_waitcnt lgkmcnt(0)" ::: "memory"); __builtin_amdgcn_s_barrier(); asm volatile("" ::: "memory"); } while (0)

namespace pg8 {
constexpr int BM = 256, BK = 64, HALF = 128, HTB = HALF * BK * 2, STAGE_BYTES = 8 * HTB, NXCD = 8, WGM = 8;
__host__ __device__ __forceinline__ int lds_byte(int r, int c) { const int st = (r >> 4) * 2 + (c >> 5), rr = r & 15, cc = c & 31, ob = rr * 64 + cc * 2; return st * 1024 + (ob ^ (((ob >> 9) & 1) << 5)); }
__host__ __device__ __forceinline__ void stage_rc(int b, int& R, int& C) { const int st = b / 1024, sb = b % 1024, swz = sb ^ (((sb >> 9) & 1) << 5); R = (st >> 1) * 16 + swz / 64; C = (st & 1) * 32 + (swz % 64) / 2; }
__host__ __device__ __forceinline__ int perm32(int rho) { const int n = rho >> 4, i = rho & 15; return 8 * (i >> 2) + 4 * n + (i & 3); }

struct Unit { int pm, pn; };
struct Gemm { const bf16_t* A; const bf16_t* Bt; int M, N, K, lda, ldb; };

struct StaticOrder {
    int nM, nN, nwg, G, c;
    __device__ void init(int M, int N, int G_, int c_) { nM = M / BM; nN = N / BM; nwg = nM * nN; G = G_; c = c_; }
    __device__ bool next(int i, Unit& u) const {
        const long L = (long)i * G + c; if (L >= nwg) return false;
        int wgid = (int)L; { const int q = nwg / NXCD, r = nwg % NXCD, xcd = wgid % NXCD, off = wgid / NXCD; wgid = (xcd < r ? xcd * (q + 1) : r * (q + 1) + (xcd - r) * q) + off; }
        const int nig = WGM * nN, gid = wgid / nig, fm = gid * WGM, gsz = (nM - fm) < WGM ? (nM - fm) : WGM;
        u.pm = fm + ((wgid % nig) % gsz); u.pn = (wgid % nig) / gsz; return true;
    }
};


struct EpiProj {
    bf16_t* G;
    const float* bgate; const float* gqd; const float* gkd; const float* gkm; const int* pos;
    __device__ __forceinline__ void operator()(const f32x4 (&acc)[2][2][4][2], const Unit& u, int wr, int wc, int fr, int fq) const {
        const int row0 = u.pm * BM + wr * 64 + fr; const int pn = u.pn;
        unsigned char* const wsb = (unsigned char*)G - WS_G;
        bf16_t* const DV = (bf16_t*)(wsb + WS_DV); bf16_t* const RAWQ = (bf16_t*)(wsb + WS_RAWQ); bf16_t* const RAWKV = (bf16_t*)(wsb + WS_RAWKV); float* const SSQ = (float*)(wsb + WS_SSQ);
        bf16_t* const DQ = (bf16_t*)(wsb + WS_DQ); bf16_t* const DK = (bf16_t*)(wsb + WS_DK); bf16_t* const KPE = (bf16_t*)(wsb + WS_KPE);
        if (pn < 16) {
            const int ch0 = pn * 128 + wc * 32 + 8 * fq;
            bf16_t* const gr_ = G;
#pragma unroll
            for (int ai = 0; ai < 2; ++ai)
#pragma unroll
                for (int m = 0; m < 4; ++m) { const size_t off = (size_t)(row0 + ai * HALF + m * 16) * 2048 + ch0; float rr[8], gg[8];
#pragma unroll
                    for (int n = 0; n < 2; ++n) { const f32x4 ba = *(const f32x4*)(bgate + ch0 + 4 * n), bb = *(const f32x4*)(bgate + 2048 + ch0 + 4 * n);
#pragma unroll
                        for (int j = 0; j < 4; ++j) { const float ea = __builtin_amdgcn_exp2f(-(acc[ai][0][m][n][j] + ba[j]) * LOG2E), eb = __builtin_amdgcn_exp2f(-(acc[ai][1][m][n][j] + bb[j]) * LOG2E);
                            gg[4 * n + j] = __builtin_amdgcn_rcpf(1.0f + eb); rr[4 * n + j] = (1.0f + eb) * __builtin_amdgcn_rcpf(1.0f + ea); } }
                    *(u32x4*)(gr_ + off) = pack8(rr); *(u32x4*)(gr_ + (size_t)MT * 2048 + off) = pack8(gg);
                    asm volatile("" ::: "memory"); }
        } else if (pn < 23) {
            const bool gate = false;
            bf16_t* const p0 = G; bf16_t* const p1 = DV; bf16_t* const p2 = RAWQ; bf16_t* const p3 = RAWKV;
            bf16_t* base = pn < 16 ? p0 : (pn < 20 ? p1 : (pn < 22 ? p2 : p3));
            const int colt = pn < 16 ? pn * BM : (pn < 20 ? (pn - 16) * BM : (pn < 22 ? (pn - 20) * BM : 0));
            const int psh = pn < 16 ? 12 : (pn < 20 ? 10 : (pn < 22 ? 9 : 8));
            const int col0 = colt + wc * 32 + 8 * fq;
            f32x4 bv[2][2];
#pragma unroll
            for (int bj = 0; bj < 2; ++bj)
#pragma unroll
                for (int n = 0; n < 2; ++n) bv[bj][n] = gate ? *(const f32x4*)(bgate + col0 + bj * HALF + 4 * n) : (f32x4){0.f, 0.f, 0.f, 0.f};
#pragma unroll
            for (int ai = 0; ai < 2; ++ai)
#pragma unroll
                for (int m = 0; m < 4; ++m) { const int row = row0 + ai * HALF + m * 16; bf16_t* rowp = base + ((size_t)row << psh) + col0; float ss = 0.f;
#pragma unroll
                    for (int bj = 0; bj < 2; ++bj) { f32x4 v0 = acc[ai][bj][m][0] + bv[bj][0], v1 = acc[ai][bj][m][1] + bv[bj][1];
                        if (gate) {
#pragma unroll
                            for (int j = 0; j < 4; ++j) { v0[j] = sigmoidf_fast(v0[j]); v1[j] = sigmoidf_fast(v1[j]); } }
                        ss += (v0[0] * v0[0] + v0[1] * v0[1]) + (v0[2] * v0[2] + v0[3] * v0[3]) + (v1[0] * v1[0] + v1[1] * v1[1]) + (v1[2] * v1[2] + v1[3] * v1[3]);
                        u32x4 w; w.x = pk_bf16(v0[0], v0[1]); w.y = pk_bf16(v0[2], v0[3]); w.z = pk_bf16(v1[0], v1[1]); w.w = pk_bf16(v1[2], v1[3]);
                        *(u32x4*)(rowp + bj * HALF) = w; }
                    if (pn >= 20) { ss += __shfl_xor(ss, 16); ss += __shfl_xor(ss, 32); if (fq == 0) SSQ[(size_t)row * 12 + (pn - 20) * 4 + wc] = ss; } }
        } else {
            const bool isq = pn < 27, iskpe = pn == 31;
            if (iskpe && wc != 0) return;
            const float* const ga = gqd; const float* const gb = gkd; const float* const gc = gkm + 128;
            const float* gp = isq ? ga : (iskpe ? gc : gb);
            bf16_t* const o0 = DQ; bf16_t* const o1 = DK; bf16_t* const o2 = KPE;
            bf16_t* ob = isq ? o0 : (iskpe ? o2 : o1);
            const int osh = iskpe ? 6 : 10, grp = iskpe ? 0 : 4 * (pn - (isq ? 23 : 27)) + wc;
            const float qs = isq ? QS_DIFF : 1.0f;
            f32x4 g0[2], g1[2]; float invf[2][4];
#pragma unroll
            for (int n = 0; n < 2; ++n) { g0[n] = *(const f32x4*)(gp + 8 * fq + 4 * n); g1[n] = *(const f32x4*)(gp + 32 + 8 * fq + 4 * n);
#pragma unroll
                for (int j = 0; j < 4; ++j) invf[n][j] = rope_invf(8 * fq + 4 * n + j); }
#pragma unroll
            for (int ai = 0; ai < 2; ++ai)
#pragma unroll
                for (int m = 0; m < 4; ++m) { const int row = row0 + ai * HALF + m * 16; const float posf = (float)pos[row];
                    float ss = 0.f;
#pragma unroll
                    for (int bj = 0; bj < 2; ++bj)
#pragma unroll
                        for (int n = 0; n < 2; ++n) { const f32x4 x = acc[ai][bj][m][n]; ss += (x[0] * x[0] + x[1] * x[1]) + (x[2] * x[2] + x[3] * x[3]); }
                    ss += __shfl_xor(ss, 16); ss += __shfl_xor(ss, 32);
                    const float rs = qs / sqrtf(ss * (1.0f / 64.0f) + EPS);
                    float lo[8], hi8[8];
#pragma unroll
                    for (int n = 0; n < 2; ++n)
#pragma unroll
                        for (int j = 0; j < 4; ++j) { float cs, sn; rope_cs2(posf, invf[n][j], cs, sn);
                            const float a = acc[ai][0][m][n][j] * g0[n][j], b = acc[ai][1][m][n][j] * g1[n][j];
                            lo[4 * n + j] = rs * (a * cs - b * sn); hi8[4 * n + j] = rs * (b * cs + a * sn); }
                    bf16_t* op = ob + ((size_t)row << osh) + 64 * grp + 8 * fq;
                    *(u32x4*)op = pack8(lo); *(u32x4*)(op + 32) = pack8(hi8); }
        }
    }
};
struct EpiQ {
    bf16_t* QM; const float* SSQ; const float* gq; const int* pos; LAS float* xch;
    __device__ __forceinline__ void operator()(const f32x4 (&acc)[2][2][4][2], const Unit& u, int wr, int wc, int fr, int fq) const {
        const int row0 = u.pm * BM + wr * 64 + fr; const int hb = u.pn / 3, tt = u.pn % 3;
#define EPI_SS16(dst) do { float ss_ = 0.f; _Pragma("unroll") for (int bj = 0; bj < 2; ++bj) _Pragma("unroll") for (int n = 0; n < 2; ++n) { const f32x4 x = acc[ai][bj][m][n]; ss_ += (x[0] * x[0] + x[1] * x[1]) + (x[2] * x[2] + x[3] * x[3]); } \
        ss_ += __shfl_xor(ss_, 16); ss_ += __shfl_xor(ss_, 32); dst = ss_; } while (0)
#define EPI_RQ(dst, row) do { const float* sp_ = SSQ + (size_t)(row) * 12; const f32x4 a_ = *(const f32x4*)sp_, b_ = *(const f32x4*)(sp_ + 4); \
        dst = 1.0f / sqrtf(((a_[0] + a_[1]) + (a_[2] + a_[3]) + (b_[0] + b_[1]) + (b_[2] + b_[3])) * (1.0f / 512.0f) + EPS); } while (0)
        if (tt < 2) {
            const int h = 4 * hb + 2 * tt + (wc >> 1), gg = wc & 1;
#pragma unroll
            for (int ai = 0; ai < 2; ++ai)
#pragma unroll
                for (int m = 0; m < 4; ++m) { float s1; EPI_SS16(s1); if (fq == 0) xch[(ai * HALF + wr * 64 + m * 16 + fr) * 4 + wc] = s1; }
            EPI_LDS_BAR();
            f32x4 g0[2], g1[2];
#pragma unroll
            for (int n = 0; n < 2; ++n) { g0[n] = *(const f32x4*)(gq + 64 * gg + 8 * fq + 4 * n); g1[n] = *(const f32x4*)(gq + 64 * gg + 32 + 8 * fq + 4 * n); }
#pragma unroll
            for (int ai = 0; ai < 2; ++ai)
#pragma unroll
                for (int m = 0; m < 4; ++m) { const int row = row0 + ai * HALF + m * 16; float r; EPI_RQ(r, row);
                    const LAS float* xr = xch + (ai * HALF + wr * 64 + m * 16 + fr) * 4 + (wc & 2);
                    const float tot = xr[0] + xr[1];
                    const float f = QS_MLA * r / sqrtf(r * r * tot * (1.0f / 128.0f) + EPS);
                    float lo[8], hi8[8];
#pragma unroll
                    for (int n = 0; n < 2; ++n)
#pragma unroll
                        for (int j = 0; j < 4; ++j) { lo[4 * n + j] = f * acc[ai][0][m][n][j] * g0[n][j]; hi8[4 * n + j] = f * acc[ai][1][m][n][j] * g1[n][j]; }
                    bf16_t* op = QM + (size_t)row * 1536 + 192 * h + 64 * gg + 8 * fq;
                    *(u32x4*)op = pack8(lo); *(u32x4*)(op + 32) = pack8(hi8); }
        } else {
            const int h = 4 * hb + wc;
            f32x4 g0[2], g1[2]; float invf[2][4];
#pragma unroll
            for (int n = 0; n < 2; ++n) { g0[n] = *(const f32x4*)(gq + 128 + 8 * fq + 4 * n); g1[n] = *(const f32x4*)(gq + 160 + 8 * fq + 4 * n);
#pragma unroll
                for (int j = 0; j < 4; ++j) invf[n][j] = rope_invf(8 * fq + 4 * n + j); }
#pragma unroll
            for (int ai = 0; ai < 2; ++ai)
#pragma unroll
                for (int m = 0; m < 4; ++m) { const int row = row0 + ai * HALF + m * 16; float r; EPI_RQ(r, row); const float posf = (float)pos[row];
                    float ss1; EPI_SS16(ss1);
                    const float f = QS_MLA * r / sqrtf(r * r * ss1 * (1.0f / 64.0f) + EPS);
                    float lo[8], hi8[8];
#pragma unroll
                    for (int n = 0; n < 2; ++n)
#pragma unroll
                        for (int j = 0; j < 4; ++j) { float cs, sn; rope_cs2(posf, invf[n][j], cs, sn);
                            const float a = acc[ai][0][m][n][j] * g0[n][j], b = acc[ai][1][m][n][j] * g1[n][j];
                            lo[4 * n + j] = f * (a * cs - b * sn); hi8[4 * n + j] = f * (b * cs + a * sn); }
                    bf16_t* op = QM + (size_t)row * 1536 + 192 * h + 128 + 8 * fq;
                    *(u32x4*)op = pack8(lo); *(u32x4*)(op + 32) = pack8(hi8); }
        }
    }
};
struct EpiKV {
    bf16_t* KN; bf16_t* VM; const float* SSQ; const float* gk; LAS float* xch;
    __device__ __forceinline__ void operator()(const f32x4 (&acc)[2][2][4][2], const Unit& u, int wr, int wc, int fr, int fq) const {
        const int row0 = u.pm * BM + wr * 64 + fr; const int h = u.pn;
#pragma unroll
        for (int ai = 0; ai < 2; ++ai)
#pragma unroll
            for (int m = 0; m < 4; ++m) { float s1; EPI_SS16(s1); if (fq == 0) xch[(ai * HALF + wr * 64 + m * 16 + fr) * 4 + wc] = s1; }
        EPI_LDS_BAR();
        const int gg = wc & 1;
        if (wc < 2) {
            f32x4 g0[2], g1[2];
#pragma unroll
            for (int n = 0; n < 2; ++n) { g0[n] = *(const f32x4*)(gk + 64 * gg + 8 * fq + 4 * n); g1[n] = *(const f32x4*)(gk + 64 * gg + 32 + 8 * fq + 4 * n); }
#pragma unroll
            for (int ai = 0; ai < 2; ++ai)
#pragma unroll
                for (int m = 0; m < 4; ++m) { const int row = row0 + ai * HALF + m * 16;
                    float r; { const f32x4 a_ = *(const f32x4*)(SSQ + (size_t)row * 12 + 8); r = 1.0f / sqrtf(((a_[0] + a_[1]) + (a_[2] + a_[3])) * (1.0f / 256.0f) + EPS); }
                    const LAS float* xr = xch + (ai * HALF + wr * 64 + m * 16 + fr) * 4 + (wc & 2);
                    const float tot = xr[0] + xr[1];
                    const float f = r / sqrtf(r * r * tot * (1.0f / 128.0f) + EPS);
                    float lo[8], hi8[8];
#pragma unroll
                    for (int n = 0; n < 2; ++n)
#pragma unroll
                        for (int j = 0; j < 4; ++j) { lo[4 * n + j] = f * acc[ai][0][m][n][j] * g0[n][j]; hi8[4 * n + j] = f * acc[ai][1][m][n][j] * g1[n][j]; }
                    bf16_t* op = KN + (size_t)row * 1024 + 128 * h + 64 * gg + 8 * fq;
                    *(u32x4*)op = pack8(lo); *(u32x4*)(op + 32) = pack8(hi8);
                    asm volatile("" ::: "memory"); }
        } else {
#pragma unroll
            for (int ai = 0; ai < 2; ++ai)
#pragma unroll
                for (int m = 0; m < 4; ++m) { const int row = row0 + ai * HALF + m * 16;
                    float r; { const f32x4 a_ = *(const f32x4*)(SSQ + (size_t)row * 12 + 8); r = 1.0f / sqrtf(((a_[0] + a_[1]) + (a_[2] + a_[3])) * (1.0f / 256.0f) + EPS); }
                    float lo[8], hi8[8];
#pragma unroll
                    for (int n = 0; n < 2; ++n)
#pragma unroll
                        for (int j = 0; j < 4; ++j) { lo[4 * n + j] = r * acc[ai][0][m][n][j]; hi8[4 * n + j] = r * acc[ai][1][m][n][j]; }
                    bf16_t* op = VM + (size_t)row * 1024 + 128 * h + 64 * gg + 8 * fq;
                    *(u32x4*)op = pack8(lo); *(u32x4*)(op + 32) = pack8(hi8);
                    asm volatile("" ::: "memory"); }
        }
    }
};
#undef EPI_SS16
#undef EPI_RQ
struct EpiPlain {
    bf16_t* O; int ldc;
    __device__ __forceinline__ void operator()(const f32x4 (&acc)[2][2][4][2], const Unit& u, int wr, int wc, int fr, int fq) const {
        const int row0 = u.pm * BM + wr * 64 + fr; const int col0 = u.pn * BM + wc * 32 + 8 * fq;
#pragma unroll
        for (int ai = 0; ai < 2; ++ai)
#pragma unroll
            for (int m = 0; m < 4; ++m) { bf16_t* rowp = O + (size_t)(row0 + ai * HALF + m * 16) * ldc + col0;
#pragma unroll
                for (int bj = 0; bj < 2; ++bj) { const f32x4 v0 = acc[ai][bj][m][0], v1 = acc[ai][bj][m][1];
                    u32x4 w; w.x = pk_bf16(v0[0], v0[1]); w.y = pk_bf16(v0[2], v0[3]); w.z = pk_bf16(v1[0], v1[1]); w.w = pk_bf16(v1[2], v1[3]);
                    *(u32x4*)(rowp + bj * HALF) = w; } }
    }
};
template <bool ADD> struct EpiGate {
    bf16_t* O; const bf16_t* Tin; const bf16_t* Gt; int gcol;
    __device__ __forceinline__ void operator()(const f32x4 (&acc)[2][2][4][2], const Unit& u, int wr, int wc, int fr, int fq) const {
        const int row0 = u.pm * BM + wr * 64 + fr; const int col0 = u.pn * BM + wc * 32 + 8 * fq;
#pragma unroll
        for (int ai = 0; ai < 2; ++ai)
#pragma unroll
            for (int m = 0; m < 4; ++m) { const size_t row = (size_t)(row0 + ai * HALF + m * 16);
#pragma unroll
                for (int bj = 0; bj < 2; ++bj) { const f32x4 v0 = acc[ai][bj][m][0], v1 = acc[ai][bj][m][1];
                    const int col = col0 + bj * HALF;
                    const u32x4 gr = *(const u32x4*)(Gt + row * DM + gcol + col); float g[8]; unpack8(gr, g);
                    float o[8];
#pragma unroll
                    for (int j = 0; j < 4; ++j) { o[j] = g[j] * v0[j]; o[4 + j] = g[4 + j] * v1[j]; }
                    if (ADD) { const u32x4 tr = *(const u32x4*)(Tin + row * DM + col); float t[8]; unpack8(tr, t);
#pragma unroll
                        for (int j = 0; j < 8; ++j) o[j] += t[j]; }
                    *(u32x4*)(O + row * DM + col) = pack8(o); } }
    }
};
struct RatioHook {
    const bf16_t* Gt;
    __device__ __forceinline__ void operator()(f32x4 (&acc)[2][2][4][2], const Unit& u, int wr, int wc, int fr, int fq) const {
        const int row0 = u.pm * BM + wr * 64 + fr; const int col0 = u.pn * BM + wc * 32 + 8 * fq;
#pragma unroll
        for (int ai = 0; ai < 2; ++ai)
#pragma unroll
            for (int m = 0; m < 4; ++m) { const bf16_t* gp = Gt + (size_t)(row0 + ai * HALF + m * 16) * 2048 + col0;
#pragma unroll
                for (int bj = 0; bj < 2; ++bj) {
                    const u32x4 ar = *(const u32x4*)(gp + bj * HALF);
                    float a[8]; unpack8(ar, a);
#pragma unroll
                    for (int j = 0; j < 4; ++j) { acc[ai][bj][m][0][j] *= a[j]; acc[ai][bj][m][1][j] *= a[4 + j]; }
                    asm volatile("" : "+v"(acc[ai][bj][m][0]), "+v"(acc[ai][bj][m][1]) :: "memory"); __builtin_amdgcn_sched_barrier(0);
                } }
    }
};
struct EpiRes1 {
    const float* base; bf16_t* out; const float* gatev;
    __device__ __forceinline__ void operator()(const f32x4 (&acc)[2][2][4][2], const Unit& u, int wr, int wc, int fr, int fq) const {
        const int row0 = u.pm * BM + wr * 64 + fr; const int col0 = u.pn * BM + wc * 32 + 8 * fq;
        const float* gp = gatev + (size_t)(u.pm >> 4) * (6 * DM);
        f32x4 gv[2][2];
#pragma unroll
        for (int bj = 0; bj < 2; ++bj)
#pragma unroll
            for (int n = 0; n < 2; ++n) gv[bj][n] = *(const f32x4*)(gp + col0 + bj * HALF + 4 * n);
#pragma unroll
        for (int ai = 0; ai < 2; ++ai)
#pragma unroll
            for (int m = 0; m < 4; ++m) { const size_t off = (size_t)(row0 + ai * HALF + m * 16) * DM + col0;
#pragma unroll
                for (int bj = 0; bj < 2; ++bj) { const f32x4 b0 = *(const f32x4*)(base + off + bj * HALF), b1 = *(const f32x4*)(base + off + bj * HALF + 4);
                    const f32x4 v0 = b0 + gv[bj][0] * acc[ai][bj][m][0], v1 = b1 + gv[bj][1] * acc[ai][bj][m][1];
                    u32x4 w; w.x = pk_bf16(v0[0], v0[1]); w.y = pk_bf16(v0[2], v0[3]); w.z = pk_bf16(v1[0], v1[1]); w.w = pk_bf16(v1[2], v1[3]);
                    *(u32x4*)(out + off + bj * HALF) = w; } }
    }
};
struct EpiRes2 {
    const bf16_t* base; float* out; const float* gatev;
    __device__ __forceinline__ void operator()(const f32x4 (&acc)[2][2][4][2], const Unit& u, int wr, int wc, int fr, int fq) const {
        const int row0 = u.pm * BM + wr * 64 + fr; const int col0 = u.pn * BM + wc * 32 + 8 * fq;
        const float* gp = gatev + (size_t)(u.pm >> 4) * (6 * DM);
        f32x4 gv[2][2];
#pragma unroll
        for (int bj = 0; bj < 2; ++bj)
#pragma unroll
            for (int n = 0; n < 2; ++n) gv[bj][n] = *(const f32x4*)(gp + col0 + bj * HALF + 4 * n);
#pragma unroll
        for (int ai = 0; ai < 2; ++ai)
#pragma unroll
            for (int m = 0; m < 4; ++m) { const size_t off = (size_t)(row0 + ai * HALF + m * 16) * DM + col0;
#pragma unroll
                for (int bj = 0; bj < 2; ++bj) { const u32x4 br = *(const u32x4*)(base + off + bj * HALF); float bs[8]; unpack8(br, bs);
                    *(f32x4*)(out + off + bj * HALF) = (f32x4){bs[0], bs[1], bs[2], bs[3]} + gv[bj][0] * acc[ai][bj][m][0];
                    *(f32x4*)(out + off + bj * HALF + 4) = (f32x4){bs[4], bs[5], bs[6], bs[7]} + gv[bj][1] * acc[ai][bj][m][1]; } }
    }
};
__device__ __forceinline__ float dpp_shift1(float cur, float prev) {
    const int t = __builtin_amdgcn_update_dpp(0, __float_as_int(prev), 0x121, 0xf, 0xf, false);
    return __int_as_float(__builtin_amdgcn_update_dpp(t, __float_as_int(cur), 0x111, 0xf, 0xf, false));
}
__device__ __forceinline__ float dpp_shift2(float cur, float prev) {
    const int t = __builtin_amdgcn_update_dpp(0, __float_as_int(prev), 0x122, 0xf, 0xf, false);
    return __int_as_float(__builtin_amdgcn_update_dpp(t, __float_as_int(cur), 0x112, 0xf, 0xf, false));
}
struct EpiConv {
    bf16_t* ACT; float* SIDE; const float* cw; const float* cb;
    __device__ __forceinline__ void operator()(const f32x4 (&acc)[2][2][4][2], const Unit& u, int wr, int wc, int fr, int fq) const {
#pragma unroll
        for (int n = 0; n < 2; ++n) {
            const int ch = u.pn * 128 + wc * 32 + 8 * fq + 4 * n;
            const f32x4 w0v = *(const f32x4*)(cw + ch), w1v = *(const f32x4*)(cw + NUP + ch), w2v = *(const f32x4*)(cw + 2 * NUP + ch), bv = *(const f32x4*)(cb + ch);
            const f32x4 w0g = *(const f32x4*)(cw + DFF + ch), w1g = *(const f32x4*)(cw + NUP + DFF + ch), w2g = *(const f32x4*)(cw + 2 * NUP + DFF + ch), bg = *(const f32x4*)(cb + DFF + ch);
#pragma unroll
            for (int ai = 0; ai < 2; ++ai) {
                const int seg = u.pm * 4 + ai * 2 + wr;
#pragma unroll
                for (int m = 0; m < 4; ++m) {
                    const f32x4 uv = acc[ai][0][m][n], ug = acc[ai][1][m][n];
                    const f32x4 pv = m ? acc[ai][0][m ? m - 1 : 0][n] : (f32x4){0.f, 0.f, 0.f, 0.f};
                    const f32x4 pg = m ? acc[ai][1][m ? m - 1 : 0][n] : (f32x4){0.f, 0.f, 0.f, 0.f};
                    f32x4 a;
#pragma unroll
                    for (int j = 0; j < 4; ++j) {
                        const float s1v = dpp_shift1(uv[j], pv[j]), s2v = dpp_shift2(uv[j], pv[j]);
                        const float s1g = dpp_shift1(ug[j], pg[j]), s2g = dpp_shift2(ug[j], pg[j]);
                        const float yv = bv[j] + w2v[j] * uv[j] + w1v[j] * s1v + w0v[j] * s2v;
                        const float yg = bg[j] + w2g[j] * ug[j] + w1g[j] * s1g + w0g[j] * s2g;
                        a[j] = yv * yg * sigmoidf_fast(yg);
                    }
                    const size_t row = (size_t)seg * 64 + m * 16 + fr;
                    if (m > 0 || fr >= 2) { u32x2 w; w.x = pk_bf16(a[0], a[1]); w.y = pk_bf16(a[2], a[3]); *(u32x2*)(ACT + row * DFF + ch) = w; }
                    if (m == 0 && fr < 2) { float* sp = SIDE + ((size_t)seg * 4 + fr) * NUP + ch; *(f32x4*)sp = uv; *(f32x4*)(sp + DFF) = ug; }
                    if (m == 3 && fr >= 14) { float* sp = SIDE + ((size_t)seg * 4 + 2 + (fr - 14)) * NUP + ch; *(f32x4*)sp = uv; *(f32x4*)(sp + DFF) = ug; }
                }
            }
        }
    }
};

struct NoHook { __device__ __forceinline__ void operator()(f32x4 (&)[2][2][4][2], const Unit&, int, int, int, int) const {} };
template <class Epi, bool HOOK = false, class Hook = NoHook>
__device__ __forceinline__ void gemm_phase(LAS unsigned char* lds, const Gemm g, const StaticOrder& S, const Epi& E, const Hook& Hk = Hook()) {
    const int tid = threadIdx.x, wid = __builtin_amdgcn_readfirstlane(tid >> 6), lane = tid & 63, wr = wid >> 2, wc = wid & 3, fr = lane & 15, fq = lane >> 4;
    const int K = g.K, nt = K / BK, lda = g.lda, ldb = g.ldb ? g.ldb : g.K;
    const size_t halfoff = (size_t)K * 2;
    unsigned voffA[2], voffB[2];
#pragma unroll
    for (int i = 0; i < 2; ++i) { int R, C; stage_rc(tid * 16 + i * 8192, R, C); const int Rb = (R & ~31) + perm32(R & 31);
        voffA[i] = (unsigned)(R * lda + C) * 2u; voffB[i] = (unsigned)(Rb * ldb + C) * 2u; }
    const size_t kstep = (size_t)(BK * 2);
    const size_t hstepA = (size_t)HALF * lda * 2, hstepB = (size_t)HALF * ldb * 2;
    const size_t tstepA = 2 * hstepA, tstepB = 2 * hstepB;
    const unsigned ldsw = (unsigned)wid * 1024u;
    const int aoff = lds_byte(wr * 64 + fr, fq * 8), boff = lds_byte(wc * 32 + fr, fq * 8);
#define PG8_SA(b, h) (((b) * 2 + (h)) * HTB)
#define PG8_SB(b, h) ((4 + (b) * 2 + (h)) * HTB)
#define PG8_STAGE(bufoff, gbase, voff) do { _Pragma("unroll") for (int _i = 0; _i < 2; ++_i) \
        __builtin_amdgcn_global_load_lds((const unsigned*)((const char*)(gbase) + (voff)[_i]), (LAS unsigned*)(lds + (bufoff) + ldsw + _i * 8192), 16, 0, 0); } while (0)
#define PG8_LDA(dst, b, h) do { _Pragma("unroll") for (int m = 0; m < 4; ++m) _Pragma("unroll") for (int k = 0; k < 2; ++k) dst[m][k] = *(const LAS bf16x8*)(lds + PG8_SA(b, h) + aoff + m * 2048 + k * 1024); } while (0)
#define PG8_LDB(dst, b, h) do { _Pragma("unroll") for (int n = 0; n < 2; ++n) _Pragma("unroll") for (int k = 0; k < 2; ++k) dst[n][k] = *(const LAS bf16x8*)(lds + PG8_SB(b, h) + boff + n * 2048 + k * 1024); } while (0)
#define PG8_MMA(ai, bj, At, Bt) do { __builtin_amdgcn_s_setprio(1); _Pragma("unroll") for (int m = 0; m < 4; ++m) _Pragma("unroll") for (int n = 0; n < 2; ++n) _Pragma("unroll") for (int k = 0; k < 2; ++k) \
        acc[ai][bj][m][n] = __builtin_amdgcn_mfma_f32_16x16x32_bf16(Bt[n][k], At[m][k], acc[ai][bj][m][n], 0, 0, 0); __builtin_amdgcn_s_setprio(0); } while (0)
#define PG8_WAIT_V(n) asm volatile("s_waitcnt vmcnt(" #n ")" ::: "memory")
#define PG8_WAIT_L(n) asm volatile("s_waitcnt lgkmcnt(" #n ")" ::: "memory")
#define PG8_BAR __builtin_amdgcn_s_barrier()
#define PG8_SCHED __builtin_amdgcn_sched_barrier(0)
    Unit cur, nxt; int ui = 0;
    if (!S.next(0, cur)) return;
    f32x4 acc[2][2][4][2];
#pragma unroll
    for (int a = 0; a < 2; ++a)
#pragma unroll
        for (int b = 0; b < 2; ++b)
#pragma unroll
            for (int m = 0; m < 4; ++m)
#pragma unroll
                for (int n = 0; n < 2; ++n) acc[a][b][m][n] = (f32x4){0.f, 0.f, 0.f, 0.f};
    bf16x8 At[4][2], B0[2][2], B1[2][2];
    const char* cA = (const char*)g.A + (size_t)cur.pm * tstepA; const char* cB = (const char*)g.Bt + (size_t)cur.pn * tstepB;
    PG8_STAGE(PG8_SB(0, 0), cB, voffB); PG8_STAGE(PG8_SB(0, 1), cB + hstepB, voffB); PG8_STAGE(PG8_SA(0, 0), cA, voffA); PG8_STAGE(PG8_SA(0, 1), cA + hstepA, voffA);
    if (wr == 1) PG8_BAR;
    PG8_WAIT_V(2); PG8_BAR;
    PG8_STAGE(PG8_SB(1, 0), cB + kstep, voffB); PG8_STAGE(PG8_SA(1, 0), cA + kstep, voffA); PG8_STAGE(PG8_SB(1, 1), cB + hstepB + kstep, voffB);
    PG8_WAIT_V(6); PG8_BAR;
    for (;;) {
        const bool has_next = HOOK ? (((ui + 1) & 1) ? (nxt = cur, true) : S.next((ui + 1) >> 1, nxt)) : S.next(ui + 1, nxt);
        const size_t nho = (HOOK && ((ui + 1) & 1)) ? halfoff : 0;
        const char* nA = has_next ? (const char*)g.A + (size_t)nxt.pm * tstepA + nho : cA; const char* nB = has_next ? (const char*)g.Bt + (size_t)nxt.pn * tstepB + nho : cB;
        for (int t = 0; t < nt; t += 2) {
            const bool last = (t == nt - 2);
            const char* a1 = cA + (size_t)(t + 1) * kstep;
            const char* a2 = last ? nA : cA + (size_t)(t + 2) * kstep; const char* b2 = last ? nB : cB + (size_t)(t + 2) * kstep;
            const char* a3 = a2 + kstep; const char* b3 = b2 + kstep;
            PG8_LDB(B0, 0, 0); PG8_LDB(B1, 0, 1); PG8_SCHED; PG8_LDA(At, 0, 0); PG8_STAGE(PG8_SA(1, 1), a1 + hstepA, voffA);
            PG8_WAIT_V(8); PG8_WAIT_L(0); PG8_BAR; PG8_MMA(0, 0, At, B0); PG8_MMA(0, 1, At, B1); PG8_BAR; PG8_SCHED;
            PG8_LDA(At, 0, 1); PG8_STAGE(PG8_SB(0, 0), b2, voffB); PG8_STAGE(PG8_SB(0, 1), b2 + hstepB, voffB); PG8_STAGE(PG8_SA(0, 0), a2, voffA);
            PG8_WAIT_V(8); PG8_WAIT_L(0); PG8_BAR; PG8_MMA(1, 0, At, B0); PG8_MMA(1, 1, At, B1); PG8_BAR; PG8_SCHED;
            PG8_LDB(B0, 1, 0); PG8_LDB(B1, 1, 1); PG8_SCHED; PG8_LDA(At, 1, 0); PG8_STAGE(PG8_SA(0, 1), a2 + hstepA, voffA);
            PG8_WAIT_V(8); PG8_WAIT_L(0); PG8_BAR; PG8_MMA(0, 0, At, B0); PG8_MMA(0, 1, At, B1); PG8_BAR; PG8_SCHED;
            PG8_LDA(At, 1, 1); PG8_STAGE(PG8_SB(1, 0), b3, voffB); PG8_STAGE(PG8_SB(1, 1), b3 + hstepB, voffB); PG8_STAGE(PG8_SA(1, 0), a3, voffA);
            PG8_WAIT_V(8); PG8_WAIT_L(0); PG8_BAR; PG8_MMA(1, 0, At, B0); PG8_MMA(1, 1, At, B1); PG8_BAR; PG8_SCHED;
        }
        if (wr == 0) PG8_BAR;
        const bool half0 = HOOK && !(ui & 1);
        if (half0) Hk(acc, cur, wr, wc, fr, fq); else E(acc, cur, wr, wc, fr, fq);
        if (!has_next) break;
        { const float keep = half0 ? 1.0f : 0.0f;
#pragma unroll
        for (int a = 0; a < 2; ++a)
#pragma unroll
            for (int b = 0; b < 2; ++b)
#pragma unroll
                for (int m = 0; m < 4; ++m)
#pragma unroll
                    for (int n = 0; n < 2; ++n) { if (HOOK) acc[a][b][m][n] = acc[a][b][m][n] * keep; else acc[a][b][m][n] = (f32x4){0.f, 0.f, 0.f, 0.f}; } }
        cur = nxt; cA = nA; cB = nB; ++ui;
        if (wr == 1) PG8_BAR;
    }
    PG8_WAIT_V(0);
    PG8_BAR;
#undef PG8_SA
#undef PG8_SB
#undef PG8_STAGE
#undef PG8_LDA
#undef PG8_LDB
#undef PG8_MMA
#undef PG8_WAIT_V
#undef PG8_WAIT_L
#undef PG8_BAR
#undef PG8_SCHED
}
}

namespace att {
#define MFMA32(a, b, c) __builtin_amdgcn_mfma_f32_32x32x16_bf16((a), (b), (c), 0, 0, 0)
__device__ __forceinline__ int crow(int r, int hi) { return (r & 3) + 8 * (r >> 2) + 4 * hi; }
typedef short v4i16 __attribute__((ext_vector_type(4)));
template <int DQK> struct Cfg { static constexpr int KCH = DQK / 8, KROWB = DQK * 2, NKC = (64 * KCH) / 512, KBYTES = 64 * KROWB, VBYTES = 64 * 256, VOFF = 3 * KBYTES, TOTAL = 3 * KBYTES + 4 * VBYTES, NDMA = NKC + 2; };

template <int DQK>
__device__ __forceinline__ void attn_tiles(const bf16_t* __restrict__ Qg, int qpitch, const bf16_t* __restrict__ Kg, int kpitch, const bf16_t* __restrict__ Kpe,
                                           const bf16_t* __restrict__ Vg, int vpitch, int q0, LAS unsigned char* lds, f32x16 (&o)[4], float& l_out) {
    typedef Cfg<DQK> C;
    int tid_ = threadIdx.x; asm volatile("" : "+v"(tid_));
    const int tid = tid_, lane = tid & 63, r32 = lane & 31, hi = lane >> 5; const int w = __builtin_amdgcn_readfirstlane(tid >> 6);
    const int NT = (q0 + 256) / 64;
    const int tl = NT - 4 + (w >> 1);
    bf16x8 qf[DQK / 16];
    { const bf16_t* qrow = Qg + (size_t)(q0 + 32 * w + r32) * qpitch + 8 * hi;
#pragma unroll
      for (int ds = 0; ds < DQK / 16; ++ds) qf[ds] = *(const bf16x8*)(qrow + 16 * ds); }
    unsigned koff[C::NKC]; bool kpe_[C::NKC];
#pragma unroll
    for (int i = 0; i < C::NKC; ++i) { const int P = tid + 512 * i, kr = P / C::KCH, cp = P % C::KCH, kc = (cp & ~7) | ((cp ^ (kr >> 1)) & 7); kpe_[i] = (DQK == 192) && kc >= 16;
        koff[i] = kpe_[i] ? (unsigned)(kr * 64 + 8 * (kc - 16)) : (unsigned)(kr * kpitch + 8 * kc); }
    const unsigned voff = (unsigned)((tid >> 4) * vpitch + 8 * ((((((tid & 15) >> 1) ^ (2 * ((tid >> 4) & 3))) << 1) | (tid & 1))));
#define ATT_DMA(t) do { const bf16_t* kt_ = Kg + (size_t)(64 * (t)) * kpitch; const bf16_t* kp_ = Kpe + (size_t)(64 * (t)) * 64; const bf16_t* vt_ = Vg + (size_t)(64 * (t)) * vpitch; \
        LAS unsigned char* kb_ = lds + ((t) % 3) * C::KBYTES + w * 1024; LAS unsigned char* vb_ = lds + C::VOFF + ((t) & 3) * C::VBYTES + w * 1024; \
        _Pragma("unroll") for (int i = 0; i < C::NKC; ++i) __builtin_amdgcn_global_load_lds((const unsigned*)((kpe_[i] ? kp_ : kt_) + koff[i]), (LAS unsigned*)(kb_ + i * 8192), 16, 0, 0); \
        __builtin_amdgcn_global_load_lds((const unsigned*)(vt_ + voff), (LAS unsigned*)(vb_), 16, 0, 0); \
        __builtin_amdgcn_global_load_lds((const unsigned*)(vt_ + voff + 32 * vpitch), (LAS unsigned*)(vb_ + 8192), 16, 0, 0); } while (0)
#define ATT_WAITBAR(n) do { asm volatile("s_waitcnt vmcnt(%0)" :: "n"(n) : "memory"); __builtin_amdgcn_s_barrier(); asm volatile("" ::: "memory"); } while (0)
#pragma unroll
    for (int d = 0; d < 4; ++d)
#pragma unroll
        for (int i = 0; i < 16; ++i) o[d][i] = 0.f;
    float m_used = -INFINITY, l = 0.f;
    const unsigned hs16 = (unsigned)(((hi ^ (r32 >> 1)) & 7) * 16);
    const unsigned kbase = (unsigned)(r32 * C::KROWB);
    const int q4 = (lane & 15) >> 2;
    const unsigned vbase = (unsigned)(C::VOFF + (4 * hi + q4) * 256 + 32 * ((lane >> 4) & 1) + 8 * (lane & 3));
    unsigned xq[4];
#pragma unroll
    for (int db = 0; db < 4; ++db) xq[db] = (unsigned)((64 * db) ^ (64 * q4));
    bf16x8 pbp[4];
#pragma unroll
    for (int k = 0; k < 4; ++k) pbp[k] = (bf16x8){0, 0, 0, 0, 0, 0, 0, 0};
#define ATT_VLOAD1(ks, db) do { \
        const v4i16 lo_ = __builtin_amdgcn_ds_read_tr16_b64_v4i16((LAS v4i16*)(vp_ + (16 * (ks)) * 256 + xq[db])); \
        const v4i16 hh_ = __builtin_amdgcn_ds_read_tr16_b64_v4i16((LAS v4i16*)(vp_ + (16 * (ks) + 8) * 256 + xq[db])); \
        vf[db] = (bf16x8){lo_[0], lo_[1], lo_[2], lo_[3], hh_[0], hh_[1], hh_[2], hh_[3]}; } while (0)
#define ATT_PV_PLAIN(tp) do { const LAS unsigned char* vp_ = lds + vbase + ((tp) & 3) * C::VBYTES; bf16x8 vf[4]; \
        _Pragma("unroll") for (int db = 0; db < 4; ++db) ATT_VLOAD1(0, db); \
        _Pragma("unroll") for (int ks = 0; ks < 4; ++ks) { \
            _Pragma("unroll") for (int db = 0; db < 4; ++db) { o[db] = MFMA32(vf[db], pbp[ks], o[db]); if (ks < 3) ATT_VLOAD1(ks + 1, db); __builtin_amdgcn_sched_barrier(0); } } } while (0)
typedef float f32x2p __attribute__((ext_vector_type(2)));
#define ATT_EXP2P(S, a) do { f32x2p v_ = (f32x2p){S[a], S[(a) + 1]} + nm2; v_.x = __builtin_amdgcn_exp2f(v_.x); v_.y = __builtin_amdgcn_exp2f(v_.y); S[a] = v_.x; S[(a) + 1] = v_.y; ps2 = ps2 + v_; } while (0)
#define ATT_EXP2(k) do { if ((k) < 8) ATT_EXP2P(s0, 2 * (k)); else ATT_EXP2P(s1, 2 * ((k) - 8)); } while (0)
#define ATT_PACK() do { _Pragma("unroll") for (int s = 0; s < 2; ++s) { u32x4 a, b; \
        a.x = pk_bf16(s0[8 * s + 0], s0[8 * s + 1]); a.y = pk_bf16(s0[8 * s + 2], s0[8 * s + 3]); a.z = pk_bf16(s0[8 * s + 4], s0[8 * s + 5]); a.w = pk_bf16(s0[8 * s + 6], s0[8 * s + 7]); \
        b.x = pk_bf16(s1[8 * s + 0], s1[8 * s + 1]); b.y = pk_bf16(s1[8 * s + 2], s1[8 * s + 3]); b.z = pk_bf16(s1[8 * s + 4], s1[8 * s + 5]); b.w = pk_bf16(s1[8 * s + 6], s1[8 * s + 7]); \
        pbp[s] = __builtin_bit_cast(bf16x8, a); pbp[2 + s] = __builtin_bit_cast(bf16x8, b); } } while (0)
    ATT_DMA(0); ATT_DMA(1);
    ATT_WAITBAR(C::NDMA);
    int kst = 0;
    for (int t = 0; t < NT; ++t) {
        const bool more = (t + 2 < NT);
        if (more) ATT_DMA(t + 2);
        if (t <= tl) {
        f32x16 s0, s1;
        {
            const LAS unsigned char* kp0 = lds + kst * C::KBYTES + kbase;
#pragma unroll
            for (int i = 0; i < 16; ++i) { s0[i] = 0.f; s1[i] = 0.f; }
            bf16x8 ka[2], kb[2];
            { const unsigned a0 = hs16; ka[0] = *(const LAS bf16x8*)(kp0 + a0); kb[0] = *(const LAS bf16x8*)(kp0 + 32 * C::KROWB + a0); }
#pragma unroll
            for (int ds = 0; ds < DQK / 16; ++ds) {
                if (ds + 1 < DQK / 16) { const unsigned a1 = (unsigned)(16 * ((2 * (ds + 1)) & ~7)) + ((unsigned)(16 * ((2 * (ds + 1)) & 7)) ^ hs16);
                    ka[(ds + 1) & 1] = *(const LAS bf16x8*)(kp0 + a1); kb[(ds + 1) & 1] = *(const LAS bf16x8*)(kp0 + 32 * C::KROWB + a1); }
                s0 = MFMA32(ka[ds & 1], qf[ds], s0); s1 = MFMA32(kb[ds & 1], qf[ds], s1);
                __builtin_amdgcn_sched_barrier(0);
            }
        }
        const int jb = t - (NT - 4);
        if (jb >= 0) {
            const int qrel = 32 * w + r32 - 64 * jb - 4 * hi;
#pragma unroll
            for (int i = 0; i < 16; ++i) { if ((i & 3) + 8 * (i >> 2) > qrel) s0[i] = -INFINITY; if ((i & 3) + 8 * (i >> 2) + 32 > qrel) s1[i] = -INFINITY; }
        }
        if (t == 0) {
            float rm = fmaxf(s0[0], s1[0]);
#pragma unroll
            for (int i = 1; i < 16; ++i) rm = fmaxf(rm, fmaxf(s0[i], s1[i]));
            m_used = fmaxf(rm, __shfl_xor(rm, 32));
        }
        float ps_tile;
        {
            const LAS unsigned char* vp_ = lds + vbase + ((t ? t - 1 : 0) & 3) * C::VBYTES; bf16x8 vf[4];
            f32x2p ps2 = (f32x2p){0.f, 0.f}; const f32x2p nm2 = (f32x2p){-m_used, -m_used};
#pragma unroll
            for (int db = 0; db < 4; ++db) ATT_VLOAD1(0, db);
#pragma unroll
            for (int ks = 0; ks < 4; ++ks) {
#pragma unroll
                for (int db = 0; db < 4; ++db) { o[db] = MFMA32(vf[db], pbp[ks], o[db]); if (ks < 3) ATT_VLOAD1(ks + 1, db); ATT_EXP2(4 * ks + db); __builtin_amdgcn_sched_barrier(0); } }
            const float ps = ps2.x + ps2.y; l += ps; ps_tile = ps;
            ATT_PACK();
        }
        const float pst = ps_tile + __shfl_xor(ps_tile, 32);
        if (__any(pst > 4096.0f)) {
            const float gr = fmaxf(0.0f, __builtin_log2f(pst)); const float alpha = __builtin_amdgcn_exp2f(-gr); const float mn = m_used + gr;
            l *= alpha; m_used = mn;
#pragma unroll
            for (int d = 0; d < 4; ++d)
#pragma unroll
                for (int i = 0; i < 16; ++i) o[d][i] *= alpha;
#pragma unroll
            for (int k = 0; k < 4; ++k) { u32x4 pw = __builtin_bit_cast(u32x4, pbp[k]);
                pw.x = pk_bf16(bf_lo(pw.x) * alpha, bf_hi(pw.x) * alpha); pw.y = pk_bf16(bf_lo(pw.y) * alpha, bf_hi(pw.y) * alpha);
                pw.z = pk_bf16(bf_lo(pw.z) * alpha, bf_hi(pw.z) * alpha); pw.w = pk_bf16(bf_lo(pw.w) * alpha, bf_hi(pw.w) * alpha);
                pbp[k] = __builtin_bit_cast(bf16x8, pw); }
        }
        if (t == tl) ATT_PV_PLAIN(t);
        }
        if (more) ATT_WAITBAR(C::NDMA); else ATT_WAITBAR(0);
        kst = (kst == 2) ? 0 : kst + 1;
    }
    asm volatile("" ::: "memory"); __builtin_amdgcn_s_barrier(); asm volatile("" ::: "memory");
    l_out = l + __shfl_xor(l, 32);
#undef ATT_DMA
#undef ATT_WAITBAR
#undef ATT_VLOAD1
#undef ATT_PV_PLAIN
#undef ATT_EXP2
#undef ATT_EXP2P
#undef ATT_PACK
}
}

constexpr int NWAVES = 8, NTHREADS = 512;
constexpr int LDS_BYTES = 163840, MISC_OFF = 163584;
struct Args { const void* in[29]; float* out; unsigned char* ws; int ph_lo, ph_hi; };

struct Frame {
    LAS unsigned char* lds; int tid, lane, wave, G, gw, NGW;

};

__device__ __forceinline__ void transpose_item(const float* W, int Kp, int N, bf16_t* WT, int k0, int n0, int dst_row0, int hi_extra, const float* kgain, LAS float* scr, int lane) {
    const float* wp = W + (size_t)(k0 + (lane >> 4)) * N + n0 + 4 * (lane & 15);
    f32x4 v[16];
#pragma unroll
    for (int i = 0; i < 16; ++i) v[i] = *(const f32x4*)(wp + (size_t)(4 * i) * N);
    if (kgain) {
#pragma unroll
        for (int i = 0; i < 16; ++i) v[i] = v[i] * kgain[k0 + 4 * i + (lane >> 4)]; }
#pragma unroll
    for (int i = 0; i < 16; ++i) { LAS float* d = scr + (4 * i + (lane >> 4)) * 65 + 4 * (lane & 15); d[0] = v[i].x; d[1] = v[i].y; d[2] = v[i].z; d[3] = v[i].w; }
    asm volatile("s_waitcnt lgkmcnt(0)" ::: "memory");
    const int c = lane >> 3;
#pragma unroll
    for (int j = 0; j < 8; ++j) { const int n = (lane & 7) + 8 * j; const LAS float* s = scr + (8 * c) * 65 + n;
        u32x4 o; o.x = pk_bf16(s[0 * 65], s[1 * 65]); o.y = pk_bf16(s[2 * 65], s[3 * 65]); o.z = pk_bf16(s[4 * 65], s[5 * 65]); o.w = pk_bf16(s[6 * 65], s[7 * 65]);
        *(u32x4*)(WT + (size_t)(dst_row0 + n + (n >= 32 ? hi_extra : 0)) * Kp + k0 + 8 * c) = o; }
    asm volatile("s_waitcnt lgkmcnt(0)" ::: "memory");
}
__device__ __forceinline__ void transpose_weight(const Frame& F, const float* W, int K, int N, bf16_t* WT, int mode, int Kp = 0, const float* kgain = nullptr) {
    if (Kp == 0) Kp = K;
    LAS float* scr = (LAS float*)(F.lds + F.wave * 16640);
    const int nblk = N / 64, nitems = (K / 64) * nblk;
    for (int it = F.gw; it < nitems; it += F.NGW) {
        const int kb = it / nblk, nb = it % nblk, n0 = 64 * nb; int dst = n0;
        int hx = 0;
        if (mode == 1) {
            if (n0 >= R_END) { const int gc = n0 - R_END, isb = gc >= 2048, c = gc - isb * 2048; dst = 256 * (c >> 7) + 128 * isb + (c & 127); }
            else if (n0 >= R_DV) dst = 4096 + (n0 - R_DV);
            else if (n0 < R_KPE) dst = 5120 + n0;
            else if (n0 < R_DQ) { dst = 256 * 31; hx = 96; }
            else { const int g = (n0 - R_DQ) >> 6; dst = 256 * (23 + (g >> 2)) + 32 * (g & 3); hx = 96; }
        }
        if (mode == 2) { const int isg = n0 >= DFF, c = n0 - isg * DFF; dst = 256 * (c >> 7) + 128 * isg + (c & 127); }
        if (mode == 3) { const int h = n0 / 192, blk = (n0 % 192) >> 6, hb = h >> 2, hq = h & 3;
            dst = blk < 2 ? 256 * (3 * hb + (hq >> 1)) + 32 * (2 * (hq & 1) + blk) : 256 * (3 * hb + 2) + 32 * hq; hx = 96; }
        if (mode == 4) { dst = 256 * (n0 >> 8) + 32 * ((n0 & 255) >> 6); hx = 96; }
        transpose_item(W, Kp, N, WT, 64 * kb, n0, dst, hx, kgain, scr, F.lane);
    }
}
__device__ __forceinline__ void modnorm_rows(const Frame& F, const float* X, const float* g, const float* shift, const float* scale, bf16_t* out) {
    for (int m = F.gw; m < MT; m += 2 * F.NGW) {
        const int m1 = (m + F.NGW < MT) ? m + F.NGW : m;
        const int b0 = m >> 12, b1 = m1 >> 12;
        const f32x4* xr0 = (const f32x4*)(X + (size_t)m * DM) + F.lane; const f32x4* xr1 = (const f32x4*)(X + (size_t)m1 * DM) + F.lane;
        f32x4 v0[8], v1[8];
#pragma unroll
        for (int j = 0; j < 8; ++j) v0[j] = xr0[64 * j];
#pragma unroll
        for (int j = 0; j < 8; ++j) v1[j] = xr1[64 * j];
        float s0 = 0.f, s1 = 0.f;
#pragma unroll
        for (int j = 0; j < 8; ++j) { s0 += (v0[j].x * v0[j].x + v0[j].y * v0[j].y) + (v0[j].z * v0[j].z + v0[j].w * v0[j].w); s1 += (v1[j].x * v1[j].x + v1[j].y * v1[j].y) + (v1[j].z * v1[j].z + v1[j].w * v1[j].w); }
        const float rs0 = 1.0f / sqrtf(wave_sum(s0) * (1.0f / DM) + EPS), rs1 = 1.0f / sqrtf(wave_sum(s1) * (1.0f / DM) + EPS);
        u32x2* o0 = (u32x2*)(out + (size_t)m * DM) + F.lane; u32x2* o1 = (u32x2*)(out + (size_t)m1 * DM) + F.lane;
#pragma unroll
        for (int j = 0; j < 8; ++j) { const int col = 256 * j + 4 * F.lane;
            const f32x4 gg = *(const f32x4*)(g + col);
            const f32x4 sc0 = *(const f32x4*)(scale + (size_t)b0 * 6 * DM + col), sh0 = *(const f32x4*)(shift + (size_t)b0 * 6 * DM + col);
            const f32x4 sc1 = *(const f32x4*)(scale + (size_t)b1 * 6 * DM + col), sh1 = *(const f32x4*)(shift + (size_t)b1 * 6 * DM + col);
            const f32x4 y0 = v0[j] * rs0 * gg * (sc0 + 1.0f) + sh0, y1 = v1[j] * rs1 * gg * (sc1 + 1.0f) + sh1;
            u32x2 w0; w0.x = pk_bf16(y0.x, y0.y); w0.y = pk_bf16(y0.z, y0.w); o0[64 * j] = w0;
            u32x2 w1; w1.x = pk_bf16(y1.x, y1.y); w1.y = pk_bf16(y1.z, y1.w); o1[64 * j] = w1; }
    }
}
__device__ __forceinline__ void modnorm_rows_bf16(const Frame& F, const bf16_t* X, const float* g, const float* shift, const float* scale, bf16_t* out) {
    for (int m = F.gw; m < MT; m += 2 * F.NGW) {
        const int m1 = (m + F.NGW < MT) ? m + F.NGW : m;
        const int bb[2] = {m >> 12, m1 >> 12}; const int mm[2] = {m, m1};
        u32x4 raw[2][4];
#pragma unroll
        for (int r = 0; r < 2; ++r)
#pragma unroll
            for (int j = 0; j < 4; ++j) raw[r][j] = ((const u32x4*)(X + (size_t)mm[r] * DM) + F.lane)[64 * j];
        float rs[2];
#pragma unroll
        for (int r = 0; r < 2; ++r) { float s = 0.f;
#pragma unroll
            for (int j = 0; j < 4; ++j) { float t[8]; unpack8(raw[r][j], t);
#pragma unroll
                for (int e = 0; e < 8; ++e) s += t[e] * t[e]; }
            rs[r] = 1.0f / sqrtf(wave_sum(s) * (1.0f / DM) + EPS); }
#pragma unroll
        for (int j = 0; j < 4; ++j) { const int col = 512 * j + 8 * F.lane;
#pragma unroll
            for (int r = 0; r < 2; ++r) { float t[8], y[8]; unpack8(raw[r][j], t);
#pragma unroll
                for (int hh = 0; hh < 2; ++hh) { const f32x4 gg = *(const f32x4*)(g + col + 4 * hh), sc = *(const f32x4*)(scale + (size_t)bb[r] * 6 * DM + col + 4 * hh), sh = *(const f32x4*)(shift + (size_t)bb[r] * 6 * DM + col + 4 * hh);
#pragma unroll
                    for (int e = 0; e < 4; ++e) y[4 * hh + e] = t[4 * hh + e] * rs[r] * gg[e] * (sc[e] + 1.0f) + sh[e]; }
                ((u32x4*)(out + (size_t)mm[r] * DM) + F.lane)[64 * j] = pack8(y); } }
    }
}
__device__ __forceinline__ void vtranspose(const Frame& F, const bf16_t* src, int pitch, int col0, int hstride, bf16_t* dst) {
    LAS unsigned char* T = F.lds + F.wave * 18432;
    const int lane = F.lane;
    for (int it = F.gw; it < 2048; it += F.NGW) {
        const int b = it >> 9, h = (it >> 6) & 7, sc = it & 63;
        const bf16_t* sp = src + (size_t)(b * SEQ + 64 * sc) * pitch + col0 + h * hstride;
        u32x4 rawv[16];
#pragma unroll
        for (int i = 0; i < 16; ++i) rawv[i] = *(const u32x4*)(sp + (size_t)(4 * i + (lane >> 4)) * pitch + 8 * (lane & 15));
#pragma unroll
        for (int i = 0; i < 16; ++i) { const int tok = 4 * i + (lane >> 4), ch = lane & 15;
            const u32x4 raw = rawv[i];
            const int ptok = (tok & ~12) | ((tok & 4) << 1) | ((tok & 8) >> 1);
            LAS unsigned short* tp = (LAS unsigned short*)(T + (8 * ch) * 144 + ptok * 2);
            tp[0 * 72] = (unsigned short)(raw.x & 0xffff); tp[1 * 72] = (unsigned short)(raw.x >> 16); tp[2 * 72] = (unsigned short)(raw.y & 0xffff); tp[3 * 72] = (unsigned short)(raw.y >> 16);
            tp[4 * 72] = (unsigned short)(raw.z & 0xffff); tp[5 * 72] = (unsigned short)(raw.z >> 16); tp[6 * 72] = (unsigned short)(raw.w & 0xffff); tp[7 * 72] = (unsigned short)(raw.w >> 16); }
        asm volatile("s_waitcnt lgkmcnt(0)" ::: "memory");
        bf16_t* dp = dst + (size_t)((b * 8 + h) * 128) * SEQ + 64 * sc;
#pragma unroll 4
        for (int i = 0; i < 16; ++i) { const int dv = 8 * i + (lane >> 3), c8 = lane & 7;
            const u32x4 v = *(const LAS u32x4*)(T + dv * 144 + 16 * c8);
            *(u32x4*)(dp + (size_t)dv * SEQ + 8 * c8) = v; }
        asm volatile("s_waitcnt lgkmcnt(0)" ::: "memory");
    }
}


#define XB_TMO      128
#define XB_XCNT(j)  (256  + 64 * (j))
#define XB_XSUB(j)  (1280 + 64 * (j))
#define XB_XGEN(j)  (2304 + 64 * (j))
#define XB_TOP      3328
#define XB_TOPGEN   3392
#define XCD_BAR_WORDS 3456
#define XB_SPIN_CAP (1u << 18)
__device__ __forceinline__ unsigned xb_ld(unsigned* p)              { return __hip_atomic_load(p, __ATOMIC_RELAXED, __HIP_MEMORY_SCOPE_AGENT); }
__device__ __forceinline__ unsigned xb_add(unsigned* p, unsigned v) { return __hip_atomic_fetch_add(p, v, __ATOMIC_RELAXED, __HIP_MEMORY_SCOPE_AGENT); }
__device__ __forceinline__ unsigned xb_xcc_id() { return (unsigned)__builtin_amdgcn_s_getreg((3 << 11) | 20) & 0xFu; }
#define XB_SPIN(cond, bar) do { unsigned _sp = 0; while (cond) { __builtin_amdgcn_s_sleep(1); \
    if ((++_sp & 255u) == 0u) { if (xb_ld(&(bar)[XB_TMO])) break; if (_sp > XB_SPIN_CAP) { atomicAdd(&(bar)[XB_TMO], 1u); break; } } } } while (0)
struct XcdBarrier { unsigned* bar; unsigned x; volatile LAS unsigned* st; };
__device__ __forceinline__ XcdBarrier xcd_barrier_post(unsigned* bar, volatile LAS unsigned* st) {
    XcdBarrier b; b.bar = bar; b.x = xb_xcc_id(); b.st = st;
    if (threadIdx.x == 0) (void)xb_add(&bar[XB_XCNT(b.x)], 1u);
    return b;
}
__device__ __forceinline__ void xcd_barrier_complete(unsigned* bar, unsigned x, unsigned& nloc, unsigned& nx) {
    const unsigned G = gridDim.x * gridDim.y * gridDim.z;
    unsigned sum, cnt, mine, sp = 0u;
    for (;;) {
        sum = 0u; cnt = 0u; mine = 0u;
#pragma unroll
        for (unsigned j = 0; j < 16; ++j) { const unsigned c = xb_ld(&bar[XB_XCNT(j)]); sum += c; cnt += (c > 0u) ? 1u : 0u; mine = (j == x) ? c : mine; }
        if (sum == G) break;
        __builtin_amdgcn_s_sleep(1);
        if ((++sp & 255u) == 0u) { if (xb_ld(&bar[XB_TMO])) break; if (sp > XB_SPIN_CAP) { atomicAdd(&bar[XB_TMO], 1u); break; } }
    }
    nloc = mine > 0u ? mine : 1u; nx = cnt > 0u ? cnt : 1u;
}
__device__ __forceinline__ void xcd_barrier(const XcdBarrier& b) {
    asm volatile("s_waitcnt vmcnt(0)" ::: "memory");
    __syncthreads();
    if (threadIdx.x == 0) {
        unsigned* bar = b.bar;
        __builtin_amdgcn_s_waitcnt(0);
        unsigned nloc = b.st[0], nx = b.st[1];
        if (nloc == 0u) { xcd_barrier_complete(bar, b.x, nloc, nx); b.st[0] = nloc; b.st[1] = nx; }
        const unsigned old = xb_add(&bar[XB_XSUB(b.x)], 1u);
        const unsigned gen = old / nloc;
        if (old + 1u == (gen + 1u) * nloc) {
            __builtin_amdgcn_fence(__ATOMIC_RELEASE, "agent");
            asm volatile("s_waitcnt vmcnt(0)" ::: "memory");
            const unsigned og = xb_add(&bar[XB_TOP], 1u);
            const unsigned tg = og / nx;
            if (og + 1u == (tg + 1u) * nx) xb_add(&bar[XB_TOPGEN], 1u);
            else XB_SPIN(xb_ld(&bar[XB_TOPGEN]) == tg, bar);
            __builtin_amdgcn_fence(__ATOMIC_ACQUIRE, "agent");
            xb_add(&bar[XB_XGEN(b.x)], 1u);
            asm volatile("s_waitcnt vmcnt(0)" ::: "memory");
        } else {
            XB_SPIN(xb_ld(&bar[XB_XGEN(b.x)]) == gen, bar);
            __builtin_amdgcn_fence(__ATOMIC_ACQUIRE, "agent");
            asm volatile("s_waitcnt vmcnt(0)" ::: "memory");
        }
    }
    __syncthreads();
}
constexpr int CW_BAR = 4096;
constexpr size_t CTL_ZERO_BYTES = 65536;
#define P_x ((const float*)args.in[0])
#define P_cvec ((const float*)args.in[1])
#define P_pos ((const int*)args.in[2])
#define P_w_ada ((const float*)args.in[3])
#define P_b_ada ((const float*)args.in[4])
#define P_g_norm1 ((const float*)args.in[5])
#define P_w_in ((const float*)args.in[6])
#define P_b_gate ((const float*)args.in[7])
#define P_g_q_lat ((const float*)args.in[8])
#define P_w_q_up ((const float*)args.in[9])
#define P_g_kv_lat ((const float*)args.in[10])
#define P_w_kv_up ((const float*)args.in[11])
#define P_g_q_mla ((const float*)args.in[12])
#define P_g_k_mla ((const float*)args.in[13])
#define P_w_o_mla ((const float*)args.in[14])
#define P_g_q_diff ((const float*)args.in[15])
#define P_g_k_diff ((const float*)args.in[16])
#define P_lam_q1 ((const float*)args.in[17])
#define P_lam_k1 ((const float*)args.in[18])
#define P_lam_q2 ((const float*)args.in[19])
#define P_lam_k2 ((const float*)args.in[20])
#define P_g_sub ((const float*)args.in[21])
#define P_w_o_diff ((const float*)args.in[22])
#define P_w_out ((const float*)args.in[23])
#define P_g_norm2 ((const float*)args.in[24])
#define P_w_up ((const float*)args.in[25])
#define P_conv_w ((const float*)args.in[26])
#define P_conv_b ((const float*)args.in[27])
#define P_w_down ((const float*)args.in[28])
#define P_out (args.out)
#define P_ctl ((unsigned*)(args.ws + WS_CTL))
#define P_mod ((float*)(args.ws + WS_MOD))
#define P_part ((float*)(args.ws + WS_PART))
#define P_KPE ((bf16_t*)(args.ws + WS_KPE))
#define P_WB1 ((bf16_t*)(args.ws + WS_WB1))
#define P_WQ ((bf16_t*)(args.ws + WS_WQ))
#define P_WKV ((bf16_t*)(args.ws + WS_WKV))
#define P_WOM ((bf16_t*)(args.ws + WS_WOM))
#define P_WOUT ((bf16_t*)(args.ws + WS_WOUT))
#define P_Hb ((bf16_t*)(args.ws + WS_H))
#define P_DQ ((bf16_t*)(args.ws + WS_DQ))
#define P_DK ((bf16_t*)(args.ws + WS_DK))
#define P_MIX ((bf16_t*)(args.ws + WS_MIX))
#define P_Gb ((bf16_t*)(args.ws + WS_G))
#define P_WUP ((bf16_t*)(args.ws + WS_WUP))
#define P_WDN ((bf16_t*)(args.ws + WS_WDN))
#define P_O2 ((bf16_t*)(args.ws + WS_O2))
#define P_ACT ((bf16_t*)(args.ws + WS_ACT))
#define P_SIDE ((float*)(args.ws + WS_SIDE))
#define P_X1B ((bf16_t*)(args.ws + WS_X1B))
#define P_DV ((bf16_t*)(args.ws + WS_DV))
#define P_QM ((bf16_t*)(args.ws + WS_QM))
#define P_KN ((bf16_t*)(args.ws + WS_KN))
#define P_RAWQ ((bf16_t*)(args.ws + WS_RAWQ))
#define P_RAWKV ((bf16_t*)(args.ws + WS_RAWKV))
#define P_SSQ ((float*)(args.ws + WS_SSQ))
#define P_VM ((bf16_t*)(args.ws + WS_VM))
__global__ void __launch_bounds__(NTHREADS, 2) fwd_kernel(Args args) {
    extern __shared__ __attribute__((aligned(16))) unsigned char lds_raw[];
    cg::grid_group grid = cg::this_grid();
    Frame F;
    F.lds = (LAS unsigned char*)lds_raw; F.tid = threadIdx.x; F.lane = F.tid & 63; F.wave = __builtin_amdgcn_readfirstlane(F.tid >> 6);
    F.G = gridDim.x; F.gw = blockIdx.x * NWAVES + F.wave; F.NGW = F.G * NWAVES;
    volatile LAS int* misc = (volatile LAS int*)(F.lds + MISC_OFF);
    if (F.tid < 32) misc[F.tid] = 0;
    __syncthreads();
    const XcdBarrier bar = xcd_barrier_post(P_ctl + CW_BAR, (volatile LAS unsigned*)(misc + 8));
    if (args.ph_lo < 0) grid.sync();

    const int lo = args.ph_lo, hi_ = args.ph_hi;
#ifndef PHASE_MASK
#define PHASE_MASK 0x7fff
#endif
#define IN(k) (((PHASE_MASK >> (k)) & 1) && lo <= (k) && (k) < hi_)
#define SEAM(k) do { if (IN(k) && IN((k) + 1)) xcd_barrier(bar); } while (0)
#ifndef REP_MASK
#define REP_MASK 0
#endif
#define REPS(k) ((((REP_MASK) >> (k)) & 1) ? 2 : 1)
#define PHASE(k) if (IN(k)) for (int rep = 0; rep < REPS(k); ++rep, (rep < REPS(k) ? xcd_barrier(bar) : (void)0))

    PHASE(0) {
        for (int it = blockIdx.x; it < 192; it += F.G) {
            const int e = 64 * it + F.lane, d0 = 256 * F.wave;
            float a0 = 0.f, a1 = 0.f, a2 = 0.f, a3 = 0.f;
#pragma unroll 1
            for (int dq = 0; dq < 4; ++dq) {
                float sl[4];
#pragma unroll
                for (int b = 0; b < 4; ++b) { const float cv = P_cvec[b * DM + d0 + 64 * dq + F.lane]; sl[b] = cv * sigmoidf_fast(cv); }
#pragma unroll 16
                for (int dd = 0; dd < 64; ++dd) {
                    const float wv = P_w_ada[(size_t)(d0 + 64 * dq + dd) * (6 * DM) + e];
                    a0 += wv * __shfl(sl[0], dd); a1 += wv * __shfl(sl[1], dd); a2 += wv * __shfl(sl[2], dd); a3 += wv * __shfl(sl[3], dd);
                }
            }
            LAS float* red = (LAS float*)(F.lds + 133120);
            __syncthreads();
            red[(F.wave * 4 + 0) * 64 + F.lane] = a0; red[(F.wave * 4 + 1) * 64 + F.lane] = a1; red[(F.wave * 4 + 2) * 64 + F.lane] = a2; red[(F.wave * 4 + 3) * 64 + F.lane] = a3;
            __syncthreads();
            if (F.wave < 4) { float sacc = P_b_ada[e];
#pragma unroll
                for (int w8 = 0; w8 < 8; ++w8) sacc += red[(w8 * 4 + F.wave) * 64 + F.lane];
                P_mod[F.wave * (6 * DM) + e] = sacc; }
        }
        transpose_weight(F, P_w_in, DM, 8000, P_WB1, 1);
        transpose_weight(F, P_w_q_up, 512, 1536, P_WQ, 3, 0, P_g_q_lat);
        transpose_weight(F, P_w_kv_up, 256, 2048, P_WKV, 4, 0, P_g_kv_lat);
        transpose_weight(F, P_w_o_mla, 1024, DM, P_WOM, 0, 2048);
        transpose_weight(F, P_w_o_diff, 1024, DM, P_WOM + 1024, 0, 2048);
        transpose_weight(F, P_w_out, DM, DM, P_WOUT, 0);
    }
    SEAM(0);
    PHASE(2) modnorm_rows(F, P_x, P_g_norm1, P_mod + 0 * DM, P_mod + 1 * DM, P_Hb);
    SEAM(2);
    PHASE(3) {
        pg8::Gemm g{P_Hb, P_WB1, MT, 8192, DM, DM, 0}; pg8::StaticOrder S; S.init(MT, 8192, F.G, (int)blockIdx.x);
        pg8::EpiProj E{P_Gb, P_b_gate, P_g_q_diff, P_g_k_diff, P_g_k_mla, P_pos};
        pg8::gemm_phase(F.lds, g, S, E);
    }
    SEAM(3);
    PHASE(5) {
        LAS float* xch = (LAS float*)(F.lds + 133120);
        { pg8::Gemm g{P_RAWQ, P_WQ, MT, 1536, 512, 512, 0}; pg8::StaticOrder S; S.init(MT, 1536, F.G, (int)blockIdx.x); pg8::EpiQ E{P_QM, P_SSQ, P_g_q_mla, P_pos, xch}; pg8::gemm_phase(F.lds, g, S, E); }
        { pg8::Gemm g{P_RAWKV, P_WKV, MT, 2048, 256, 256, 0}; pg8::StaticOrder S; S.init(MT, 2048, F.G, (int)blockIdx.x); pg8::EpiKV E{P_KN, P_VM, P_SSQ, P_g_k_mla, xch}; pg8::gemm_phase(F.lds, g, S, E); }
    }
    SEAM(5);
    PHASE(7) {
        float lam;
        { const float a = wave_sum(P_lam_q1[F.lane] * P_lam_k1[F.lane]), b = wave_sum(P_lam_q2[F.lane] * P_lam_k2[F.lane]); lam = expf(a) - expf(b) + LAMBDA_INIT; }
        const int lane = F.lane, r32 = lane & 31, hi = lane >> 5, w = F.wave;
        for (;;) {
            if (F.tid == 0) misc[0] = (int)__hip_atomic_fetch_add(P_ctl, 1u, __ATOMIC_RELAXED, __HIP_MEMORY_SCOPE_AGENT);
            __syncthreads();
            const int uidx = misc[0] - rep * (1024 + F.G);
            __syncthreads();
            if (uidx >= 1024) break;
            const int qb = 15 - (uidx >> 6), within = uidx & 63, kind = within >> 5, bh = within & 31, b = bh >> 3, h = bh & 7;
            const int q0 = 256 * qb; const size_t row0 = (size_t)b * SEQ; const size_t mrow = row0 + q0 + 32 * w + r32;
            f32x16 o[4]; float l;
            LAS unsigned char* const ostg = F.lds + w * 8704;
#define O_FLUSH(colbase) do { bf16_t* ob_ = P_O2 + (row0 + q0 + 32 * w) * DM + (colbase); \
        _Pragma("unroll") for (int i_ = 0; i_ < 8; ++i_) { const int rw_ = 4 * i_ + (lane >> 4); const u32x4 v_ = *(const LAS u32x4*)(ostg + rw_ * 272 + 16 * (lane & 15)); \
            *(u32x4*)(ob_ + (size_t)rw_ * DM + 8 * (lane & 15)) = v_; } } while (0)
            if (kind == 1) {
                att::attn_tiles<192>(P_QM + row0 * 1536 + 192 * h, 1536, P_KN + row0 * 1024 + 128 * h, 1024, P_KPE + row0 * 64, P_VM + row0 * 1024 + 128 * h, 1024, q0, F.lds, o, l);
                const float inv = 1.0f / l;
#pragma unroll
                for (int db = 0; db < 4; ++db)
#pragma unroll
                    for (int g = 0; g < 4; ++g) { u32x2 wv; wv.x = pk_bf16(o[db][4 * g] * inv, o[db][4 * g + 1] * inv); wv.y = pk_bf16(o[db][4 * g + 2] * inv, o[db][4 * g + 3] * inv);
                        *(LAS u32x2*)(ostg + r32 * 272 + (32 * db + 8 * g + 4 * hi) * 2) = wv; }
                O_FLUSH(128 * h);
            } else {
                const bf16_t* Vt = P_DV + row0 * 1024 + 128 * h;
                att::attn_tiles<64>(P_DQ + row0 * 1024 + 128 * h, 1024, P_DK + row0 * 1024 + 128 * h, 1024, nullptr, Vt, 1024, q0, F.lds, o, l);
                LAS unsigned* stash = (LAS unsigned*)(F.lds + att::Cfg<64>::TOTAL) + F.tid;
                { const float inv = 1.0f / l;
#pragma unroll
                  for (int db = 0; db < 4; ++db)
#pragma unroll
                      for (int g = 0; g < 4; ++g) { stash[(db * 8 + g * 2) * 512] = pk_bf16(o[db][4 * g] * inv, o[db][4 * g + 1] * inv); stash[(db * 8 + g * 2 + 1) * 512] = pk_bf16(o[db][4 * g + 2] * inv, o[db][4 * g + 3] * inv); } }
                att::attn_tiles<64>(P_DQ + row0 * 1024 + 128 * h + 64, 1024, P_DK + row0 * 1024 + 128 * h + 64, 1024, nullptr, Vt, 1024, q0, F.lds, o, l);
                const float inv2 = lam / l; float ss = 0.f;
#pragma unroll
                for (int db = 0; db < 4; ++db)
#pragma unroll
                    for (int g = 0; g < 4; ++g) {
                        const unsigned sx = stash[(db * 8 + g * 2) * 512], sy = stash[(db * 8 + g * 2 + 1) * 512];
                        const float d0 = bf_lo(sx) - inv2 * o[db][4 * g], d1 = bf_hi(sx) - inv2 * o[db][4 * g + 1];
                        const float d2 = bf_lo(sy) - inv2 * o[db][4 * g + 2], d3 = bf_hi(sy) - inv2 * o[db][4 * g + 3];
                        o[db][4 * g] = d0; o[db][4 * g + 1] = d1; o[db][4 * g + 2] = d2; o[db][4 * g + 3] = d3; ss += (d0 * d0 + d1 * d1) + (d2 * d2 + d3 * d3); }
                ss += __shfl_xor(ss, 32);
                const float rs = (1.0f - LAMBDA_INIT) / sqrtf(ss * (1.0f / 128.0f) + EPS);
#pragma unroll
                for (int db = 0; db < 4; ++db)
#pragma unroll
                    for (int g = 0; g < 4; ++g) { const int dv = 32 * db + 8 * g + 4 * hi; const f32x4 gs = *(const f32x4*)(P_g_sub + dv);
                        u32x2 wv; wv.x = pk_bf16(o[db][4 * g] * rs * gs.x, o[db][4 * g + 1] * rs * gs.y); wv.y = pk_bf16(o[db][4 * g + 2] * rs * gs.z, o[db][4 * g + 3] * rs * gs.w);
                        *(LAS u32x2*)(ostg + r32 * 272 + dv * 2) = wv; }
                O_FLUSH(1024 + 128 * h);
            }
        }
    }
#undef O_FLUSH
    SEAM(7);
    PHASE(8) { pg8::Gemm g{P_O2, P_WOM, MT, DM, 1024, 2048, 2048}; pg8::StaticOrder S; S.init(MT, DM, F.G, (int)blockIdx.x); pg8::EpiGate<false> E{P_MIX, nullptr, P_Gb + (size_t)MT * 2048, 0}; pg8::RatioHook Hk{P_Gb};
        pg8::gemm_phase<pg8::EpiGate<false>, true, pg8::RatioHook>(F.lds, g, S, E, Hk); }
    SEAM(8);
    PHASE(10) { pg8::Gemm g{P_MIX, P_WOUT, MT, DM, DM, DM, 0}; pg8::StaticOrder S; S.init(MT, DM, F.G, (int)blockIdx.x); pg8::EpiRes1 E{P_x, P_X1B, P_mod + 2 * DM}; pg8::gemm_phase(F.lds, g, S, E); }
    SEAM(10);
    PHASE(11) {
        modnorm_rows_bf16(F, P_X1B, P_g_norm2, P_mod + 3 * DM, P_mod + 4 * DM, P_Hb);
        transpose_weight(F, P_w_up, DM, NUP, P_WUP, 2);
        transpose_weight(F, P_w_down, DFF, DM, P_WDN, 0);
    }
    SEAM(11);
    PHASE(12) { pg8::Gemm g{P_Hb, P_WUP, MT, NUP, DM, DM, 0}; pg8::StaticOrder S; S.init(MT, NUP, F.G, (int)blockIdx.x); pg8::EpiConv E{P_ACT, P_SIDE, P_conv_w, P_conv_b}; pg8::gemm_phase(F.lds, g, S, E); }
    SEAM(12);
    PHASE(13) {
        for (int i = blockIdx.x * NTHREADS + F.tid; i < 256 * 2 * (DFF / 4); i += F.G * NTHREADS) {
            const int c = (i % (DFF / 4)) * 4, j = (i / (DFF / 4)) & 1, seg = i / (2 * (DFF / 4));
            const bool hasprev = (seg & 63) != 0;
            const float* sp = P_SIDE + (size_t)seg * 4 * NUP; const float* pp = P_SIDE + (size_t)(seg - 1) * 4 * NUP;
            const f32x4 z = (f32x4){0.f, 0.f, 0.f, 0.f};
            f32x4 a;
            f32x4 y[2];
#pragma unroll
            for (int hlf = 0; hlf < 2; ++hlf) {
                const int cc = c + hlf * DFF;
                const f32x4 ut = *(const f32x4*)(sp + (size_t)j * NUP + cc);
                const f32x4 u1 = j ? *(const f32x4*)(sp + cc) : (hasprev ? *(const f32x4*)(pp + (size_t)3 * NUP + cc) : z);
                const f32x4 u2 = hasprev ? *(const f32x4*)(pp + (size_t)(j ? 3 : 2) * NUP + cc) : z;
                const f32x4 w0 = *(const f32x4*)(P_conv_w + cc), w1 = *(const f32x4*)(P_conv_w + NUP + cc), w2 = *(const f32x4*)(P_conv_w + 2 * NUP + cc), bb = *(const f32x4*)(P_conv_b + cc);
                y[hlf] = bb + w2 * ut + w1 * u1 + w0 * u2;
            }
#pragma unroll
            for (int q = 0; q < 4; ++q) a[q] = y[0][q] * y[1][q] * sigmoidf_fast(y[1][q]);
            u32x2 wv; wv.x = pk_bf16(a[0], a[1]); wv.y = pk_bf16(a[2], a[3]);
            *(u32x2*)(P_ACT + ((size_t)seg * 64 + j) * DFF + c) = wv;
        }
    }
    SEAM(13);
    PHASE(14) { pg8::Gemm g{P_ACT, P_WDN, MT, DM, DFF, DFF, 0}; pg8::StaticOrder S; S.init(MT, DM, F.G, (int)blockIdx.x); pg8::EpiRes2 E{P_X1B, P_out, P_mod + 5 * DM}; pg8::gemm_phase(F.lds, g, S, E); }
#undef IN
#undef SEAM
}

#undef P_x
#undef P_cvec
#undef P_pos
#undef P_w_ada
#undef P_b_ada
#undef P_g_norm1
#undef P_w_in
#undef P_b_gate
#undef P_g_q_lat
#undef P_w_q_up
#undef P_g_kv_lat
#undef P_w_kv_up
#undef P_g_q_mla
#undef P_g_k_mla
#undef P_w_o_mla
#undef P_g_q_diff
#undef P_g_k_diff
#undef P_lam_q1
#undef P_lam_k1
#undef P_lam_q2
#undef P_lam_k2
#undef P_g_sub
#undef P_w_o_diff
#undef P_w_out
#undef P_g_norm2
#undef P_w_up
#undef P_conv_w
#undef P_conv_b
#undef P_w_down
#undef P_out
#undef P_ctl
#undef P_mod
#undef P_part
#undef P_KPE
#undef P_WB1
#undef P_WQ
#undef P_WKV
#undef P_WOM
#undef P_WOUT
#undef P_Hb
#undef P_DQ
#undef P_DK
#undef P_MIX
#undef P_Gb
#undef P_WUP
#undef P_WDN
#undef P_O2
#undef P_ACT
#undef P_SIDE
#undef P_X1B
#undef P_DV
#undef P_QM
#undef P_KN
#undef P_RAWQ
#undef P_RAWKV
#undef P_SSQ
#undef P_VM
#ifndef N_LAUNCHES
#define N_LAUNCHES 1
#endif
constexpr int N_PHASES = 15;

extern "C" void kernel_launch(void* const* d_in, const int* in_sizes, int n_in, void* d_out, int out_size, void* d_ws, size_t ws_size, hipStream_t stream) {
    static int grid = 0;
    if (grid == 0) {
        if (n_in != 29 || in_sizes[0] != MT * DM || out_size != MT * DM || ws_size < WS_END) {
            fprintf(stderr, "kernel_launch: unexpected shapes: n_in %d in0 %d out %d ws %zu (need %zu)\n", n_in, n_in > 0 ? in_sizes[0] : -1, out_size, ws_size, (size_t)WS_END); grid = -1; return; }
        int dev = 0, cus = 0, per_cu = 0;
        (void)hipGetDevice(&dev); (void)hipDeviceGetAttribute(&cus, hipDeviceAttributeMultiprocessorCount, dev);
        if (hipFuncSetAttribute((const void*)fwd_kernel, hipFuncAttributeMaxDynamicSharedMemorySize, LDS_BYTES) != hipSuccess) { fprintf(stderr, "kernel_launch: hipFuncSetAttribute failed\n"); grid = -1; return; }
        if (hipOccupancyMaxActiveBlocksPerMultiprocessor(&per_cu, (const void*)fwd_kernel, NTHREADS, LDS_BYTES) != hipSuccess || per_cu < 1) { fprintf(stderr, "kernel_launch: occupancy query says %d blocks per CU\n", per_cu); per_cu = 1; }
        (void)hipGetLastError();
        grid = cus * 1;
        if (grid <= 0) grid = 256;
    }
    if (grid < 0) return;
    if (hipMemsetAsync((char*)d_ws + WS_CTL, 0, CTL_ZERO_BYTES, stream) != hipSuccess) { fprintf(stderr, "kernel_launch: hipMemsetAsync failed\n"); return; }
    Args a{};
    for (int i = 0; i < 29; ++i) a.in[i] = d_in[i];
    a.out = (float*)d_out; a.ws = (unsigned char*)d_ws;
#if N_LAUNCHES == 1
    a.ph_lo = 0; a.ph_hi = N_PHASES;
    void* kargs[] = {&a};
    hipError_t e = hipLaunchCooperativeKernel((const void*)fwd_kernel, dim3(grid), dim3(NTHREADS), kargs, LDS_BYTES, stream);
    if (e != hipSuccess) fprintf(stderr, "kernel_launch: cooperative launch failed: %s (grid %d)\n", hipGetErrorString(e), grid);
#else
    for (int p = 0; p < N_PHASES; ++p) {
        a.ph_lo = p; a.ph_hi = p + 1;
        void* kargs[] = {&a};
        hipError_t e = hipLaunchCooperativeKernel((const void*)fwd_kernel, dim3(grid), dim3(NTHREADS), kargs, LDS_BYTES, stream);
        if (e != hipSuccess) { fprintf(stderr, "kernel_launch: launch %d failed: %s\n", p, hipGetErrorString(e)); break; }
    }
#endif
}
```
